# Optimizing an MI355X kernel written in HIP

```python
import jax, jax.numpy as jnp
from jax import lax
import numpy as np

D_MODEL = 1024
BATCH = 4
SEQ = 4096
DEPTH = 1
DEC_BATCH = 16
DEC_SEQ = 32
PAST_LEN = 1024

CHUNK = 64
N_HEADS = 16
N_KV_HEADS = 2
HEAD_DIM = 64
Q_PER_KV = N_HEADS // N_KV_HEADS
WINDOW = 128
WINDOW_CHUNKS = WINDOW // CHUNK
D_POOL = D_MODEL // 2
N_POOL_GROUPS = 4
POOL_GROUP = D_POOL // N_POOL_GROUPS
POOL_WINDOWS = (2, 4, 8, 16)
POOL_HIST = max(POOL_WINDOWS) - 1
D_Q = N_HEADS * HEAD_DIM
D_KV = N_KV_HEADS * HEAD_DIM
D_IN = D_POOL + D_Q + 2 * D_KV + 2 * D_MODEL
SPLITS = (D_POOL, D_POOL + D_Q, D_POOL + D_Q + D_KV, D_POOL + D_Q + 2 * D_KV, D_POOL + D_Q + 2 * D_KV + D_MODEL)
D_FF = 2816
EPS = 1e-6

kernel_name = "streaming_pool_swa_hybrid_step"


def rmsnorm(x, g):
    xf = x.astype(jnp.float32)
    y = xf * lax.rsqrt(jnp.mean(xf * xf, axis=-1, keepdims=True) + EPS)
    return (y * g.astype(jnp.float32)).astype(x.dtype)


def half_swiglu(x, g, w_in, w_out):
    h = rmsnorm(x, g)
    gate, up = jnp.split(h @ w_in, 2, axis=-1)
    return x + 0.5 * ((jax.nn.silu(gate) * up) @ w_out)


def multiscale_pool(u, hist, w_group, b_group, scale):
    B, S, _ = u.shape
    uf = u.astype(jnp.float32)
    if hist is None:
        ext = jnp.pad(uf, ((0, 0), (POOL_HIST, 0), (0, 0)))
    else:
        ext = jnp.concatenate([hist.astype(jnp.float32), uf], axis=1)
    cs = jnp.pad(jnp.cumsum(ext, axis=1), ((0, 0), (1, 0), (0, 0)))
    end = cs[:, POOL_HIST + 1:]
    outs = []
    for gi, w in enumerate(POOL_WINDOWS):
        sl = slice(gi * POOL_GROUP, (gi + 1) * POOL_GROUP)
        s = end[..., sl] - cs[:, POOL_HIST + 1 - w:POOL_HIST + 1 - w + S, sl]
        if hist is None:
            cnt = jnp.minimum(jnp.arange(1, S + 1), w).astype(jnp.float32)[None, :, None]
        else:
            cnt = jnp.float32(w)
        outs.append(s / cnt - uf[..., sl])
    pooled = jnp.concatenate(outs, axis=-1).reshape(B, S, N_POOL_GROUPS, POOL_GROUP)
    y = jnp.einsum('bsgc,gcd->bsgd', pooled, w_group.astype(jnp.float32)) + b_group.astype(jnp.float32)
    y = y.reshape(B, S, D_POOL) * scale.astype(jnp.float32)
    return y.astype(u.dtype)


def attend_with_sinks(qg, k, v, sinks, mask):
    s = jnp.einsum('...qkgd,...pkd->...kgqp', qg.astype(jnp.float32), k.astype(jnp.float32)) * (HEAD_DIM ** -0.5)
    if mask is not None:
        s = jnp.where(mask, s, jnp.finfo(jnp.float32).min)
    sink = sinks.astype(jnp.float32).reshape(N_KV_HEADS, Q_PER_KV)[:, :, None, None]
    m = jnp.maximum(jnp.max(s, axis=-1, keepdims=True), sink)
    p = jnp.exp(s - m)
    w = p / (jnp.sum(p, axis=-1, keepdims=True) + jnp.exp(sink - m))
    o = jnp.einsum('...kgqp,...pkd->...qkgd', w, v.astype(jnp.float32))
    return o.astype(qg.dtype)


def swa_prompt(q, k, v, sinks):
    B, S = q.shape[:2]
    nb = S // CHUNK
    qb = q.reshape(B, nb, CHUNK, N_KV_HEADS, Q_PER_KV, HEAD_DIM)
    pad = ((0, 0), (WINDOW, 0), (0, 0), (0, 0))
    kp = jnp.pad(k, pad).reshape(B, nb + WINDOW_CHUNKS, CHUNK, N_KV_HEADS, HEAD_DIM)
    vp = jnp.pad(v, pad).reshape(B, nb + WINDOW_CHUNKS, CHUNK, N_KV_HEADS, HEAD_DIM)
    kb = jnp.concatenate([kp[:, j:j + nb] for j in range(WINDOW_CHUNKS + 1)], axis=2)
    vb = jnp.concatenate([vp[:, j:j + nb] for j in range(WINDOW_CHUNKS + 1)], axis=2)
    key_chunk = jnp.arange(nb)[:, None] + jnp.arange((WINDOW_CHUNKS + 1) * CHUNK)[None, :] // CHUNK - WINDOW_CHUNKS
    mask = (key_chunk >= 0)[None, :, None, None, None, :]
    o = attend_with_sinks(qb, kb, vb, sinks, mask)
    return o.reshape(B, S, D_Q)


def swa_sample(q, k, v, k_hist, v_hist, sinks):
    B, T = q.shape[:2]
    kf = jnp.concatenate([k_hist.astype(k.dtype), k], axis=1)
    vf = jnp.concatenate([v_hist.astype(v.dtype), v], axis=1)
    o = attend_with_sinks(q.reshape(B, T, N_KV_HEADS, Q_PER_KV, HEAD_DIM), kf, vf, sinks, None)
    return o.reshape(B, T, D_Q), kf[:, -WINDOW:], vf[:, -WINDOW:]


def layer(x, hist, p):
    (norm_ffn1, ffn1_w_in, ffn1_w_out, norm_mix, w_in, b_gate, pool_w, pool_b, pool_scale,
     q_norm, k_norm, sinks, w_pool_proj, w_attn_proj, w_out, norm_ffn2, ffn2_w_in, ffn2_w_out) = p
    B, S, _ = x.shape
    x = half_swiglu(x, norm_ffn1, ffn1_w_in, ffn1_w_out)
    h = rmsnorm(x, norm_mix)
    u, q, k, v, ga, gb = jnp.split(h @ w_in, SPLITS, axis=-1)
    q = rmsnorm(q.reshape(B, S, N_HEADS, HEAD_DIM), q_norm)
    k = rmsnorm(k.reshape(B, S, N_KV_HEADS, HEAD_DIM), k_norm)
    v = v.reshape(B, S, N_KV_HEADS, HEAD_DIM)
    if hist is None:
        ya = multiscale_pool(u, None, pool_w, pool_b, pool_scale)
        yb = swa_prompt(q, k, v, sinks)
        new_pool, new_k, new_v = u[:, -POOL_HIST:], k[:, -WINDOW:], v[:, -WINDOW:]
    else:
        pool_hist, k_hist, v_hist = hist
        ya = multiscale_pool(u, pool_hist, pool_w, pool_b, pool_scale)
        yb, new_k, new_v = swa_sample(q, k, v, k_hist, v_hist, sinks)
        new_pool = jnp.concatenate([pool_hist.astype(u.dtype), u], axis=1)[:, -POOL_HIST:]
    g_a = jax.nn.sigmoid(ga + b_gate[0])
    g_b = jax.nn.sigmoid(gb + b_gate[1])
    x = x + (g_a * (ya @ w_pool_proj) + g_b * (yb @ w_attn_proj)) @ w_out
    x = half_swiglu(x, norm_ffn2, ffn2_w_in, ffn2_w_out)
    return x, new_pool, new_k, new_v


def setup_inputs(seed: int = 0) -> dict:
    key = jax.random.key(seed)
    ks = jax.random.split(key, 32)
    nrm = lambda i, shape, s: jax.random.normal(ks[i], shape, jnp.float32) * s
    gain = lambda i, shape: 1.0 + 0.05 * jax.random.normal(ks[i], shape, jnp.float32)
    L = DEPTH
    return {
        "x_prompt": nrm(0, (BATCH, SEQ, D_MODEL), 1.0),
        "x_sample": nrm(1, (DEC_BATCH, DEC_SEQ, D_MODEL), 1.0),
        "state_pool": nrm(2, (L, DEC_BATCH, POOL_HIST, D_POOL), 1.0),
        "cache_k": nrm(3, (L, DEC_BATCH, WINDOW, N_KV_HEADS, HEAD_DIM), 1.0),
        "cache_v": nrm(4, (L, DEC_BATCH, WINDOW, N_KV_HEADS, HEAD_DIM), 1.0),
        "norm_ffn1": gain(5, (L, D_MODEL)),
        "ffn1_w_in": nrm(6, (L, D_MODEL, 2 * D_FF), D_MODEL ** -0.5),
        "ffn1_w_out": nrm(7, (L, D_FF, D_MODEL), D_FF ** -0.5),
        "norm_mix": gain(8, (L, D_MODEL)),
        "w_in": nrm(9, (L, D_MODEL, D_IN), D_MODEL ** -0.5),
        "b_gate": nrm(10, (L, 2, D_MODEL), 0.1),
        "pool_w": nrm(11, (L, N_POOL_GROUPS, POOL_GROUP, POOL_GROUP), POOL_GROUP ** -0.5),
        "pool_b": nrm(12, (L, N_POOL_GROUPS, POOL_GROUP), 0.02),
        "pool_scale": gain(13, (L, D_POOL)),
        "q_norm": gain(14, (L, HEAD_DIM)),
        "k_norm": gain(15, (L, HEAD_DIM)),
        "sinks": nrm(16, (L, N_HEADS), 0.5),
        "w_pool_proj": nrm(17, (L, D_POOL, D_MODEL), D_POOL ** -0.5),
        "w_attn_proj": nrm(18, (L, D_Q, D_MODEL), D_Q ** -0.5),
        "w_out": nrm(19, (L, D_MODEL, D_MODEL), D_MODEL ** -0.5),
        "norm_ffn2": gain(20, (L, D_MODEL)),
        "ffn2_w_in": nrm(21, (L, D_MODEL, 2 * D_FF), D_MODEL ** -0.5),
        "ffn2_w_out": nrm(22, (L, D_FF, D_MODEL), D_FF ** -0.5),
    }


def reference(x_prompt, x_sample, state_pool, cache_k, cache_v, norm_ffn1, ffn1_w_in, ffn1_w_out,
              norm_mix, w_in, b_gate, pool_w, pool_b, pool_scale, q_norm, k_norm, sinks,
              w_pool_proj, w_attn_proj, w_out, norm_ffn2, ffn2_w_in, ffn2_w_out):
    xp, xs = x_prompt, x_sample
    pp, kp, vp, ps, ksm, vsm = [], [], [], [], [], []
    for l in range(DEPTH):
        p = (norm_ffn1[l], ffn1_w_in[l], ffn1_w_out[l], norm_mix[l], w_in[l], b_gate[l], pool_w[l],
             pool_b[l], pool_scale[l], q_norm[l], k_norm[l], sinks[l], w_pool_proj[l], w_attn_proj[l],
             w_out[l], norm_ffn2[l], ffn2_w_in[l], ffn2_w_out[l])
        xp, a, b, c = layer(xp, None, p)
        pp.append(a); kp.append(b); vp.append(c)
        xs, a, b, c = layer(xs, (state_pool[l], cache_k[l], cache_v[l]), p)
        ps.append(a); ksm.append(b); vsm.append(c)
    return (xp, xs, jnp.stack(pp), jnp.stack(kp), jnp.stack(vp), jnp.stack(ps), jnp.stack(ksm), jnp.stack(vsm))
```

```cpp
#include <hip/hip_runtime.h>
#include <hip/hip_cooperative_groups.h>
#include <cstdio>
#include <cstdint>
namespace cg = cooperative_groups;
namespace pg8 {
#define PG8_LAS __attribute__((address_space(3)))
typedef unsigned short bf16_t;
typedef short bf16x8 __attribute__((ext_vector_type(8)));
typedef float f32x4 __attribute__((ext_vector_type(4)));
typedef unsigned u32x4 __attribute__((ext_vector_type(4)));
constexpr int BM = 256, BK = 64, HALF = 128, HTB = HALF * BK * 2  , STAGE_BYTES = 8 * HTB, NXCD = 8, WGM = 8;

__host__ __device__ __forceinline__ int lds_byte(int r, int c) { const int st = (r >> 4) * 2 + (c >> 5), rr = r & 15, cc = c & 31, ob = rr * 64 + cc * 2; return st * 1024 + (ob ^ (((ob >> 9) & 1) << 5)); }
__host__ __device__ __forceinline__ void stage_rc(int b, int& R, int& C) { const int st = b / 1024, sb = b % 1024, swz = sb ^ (((sb >> 9) & 1) << 5); R = (st >> 1) * 16 + swz / 64; C = (st & 1) * 32 + (swz % 64) / 2; }
__host__ __device__ __forceinline__ int perm32(int rho) { const int n = rho >> 4, i = rho & 15; return 8 * (i >> 2) + 4 * n + (i & 3); }

struct Unit { int pm, pn, ks, nt; };
struct Gemm { const bf16_t* A; const bf16_t* Bt; int M, N, K, ld, ksb; };

struct StaticOrder {
    int nM, nN, nwg, G, c;
    __host__ __device__ void init(int M, int N, int G_, int c_) { nM = M / BM; nN = N / BM; nwg = nM * nN; G = G_; c = c_; }
    __host__ __device__ bool next(int i, Unit& u) const {
        const long L = (long)i * G + c; if (L >= nwg) return false;
        int wgid = (int)L; { const int q = nwg / NXCD, r = nwg % NXCD, xcd = wgid % NXCD, off = wgid / NXCD; wgid = (xcd < r ? xcd * (q + 1) : r * (q + 1) + (xcd - r) * q) + off; }
        const int nig = WGM * nN, gid = wgid / nig, fm = gid * WGM, gsz = (nM - fm) < WGM ? (nM - fm) : WGM;
        u.pm = fm + ((wgid % nig) % gsz); u.pn = (wgid % nig) / gsz; u.ks = 0; u.nt = 0; return true;
    }
    __device__ __forceinline__ void a_ready(const Unit&) const {}
    __device__ __forceinline__ void done(const Unit&) const {}
};

typedef __bf16 bf16x2_t __attribute__((ext_vector_type(2)));
typedef float f32x2_t __attribute__((ext_vector_type(2)));
__device__ __forceinline__ unsigned cvt_pk_bf16(float lo, float hi) { const f32x2_t v = {lo, hi}; const bf16x2_t b = __builtin_convertvector(v, bf16x2_t); return __builtin_bit_cast(unsigned, b); }
typedef float f32x2 __attribute__((ext_vector_type(2)));
template <class Epi, class Sched, bool ALIGN_EPI = false, bool SP2 = false>
__device__ __forceinline__ void gemm_phase(PG8_LAS unsigned char* lds, const Gemm g, const Sched& S, const Epi& E) {
    const int tid = threadIdx.x, wid = __builtin_amdgcn_readfirstlane(tid >> 6), lane = tid & 63, wr = wid >> 2, wc = wid & 3, fr = lane & 15, fq = lane >> 4;
    const int K = g.ld, nt = g.K / BK;
    const size_t sstep = (size_t)g.ksb;
    unsigned voffA[2], voffB[2];
#pragma unroll
    for (int i = 0; i < 2; ++i) { int R, C; stage_rc(tid * 16 + i * 8192, R, C); const int Rb = Epi::PERM ? ((R & ~31) + perm32(R & 31)) : R;
        voffA[i] = (unsigned)(R * K + C) * 2u; voffB[i] = (unsigned)(Rb * K + C) * 2u; }
    const size_t kstep = (size_t)(BK * 2);
    const size_t hstep = (size_t)HALF * K * 2;
    const size_t tstep = 2 * hstep;
    const unsigned ldsw = (unsigned)wid * 1024u;
    const int aoff = lds_byte(wr * 64 + fr, fq * 8), boff = lds_byte(wc * 32 + fr, fq * 8);
#define PG8_SA(b, h) (((b) * 2 + (h)) * HTB)
#define PG8_SB(b, h) ((4 + (b) * 2 + (h)) * HTB)
#define PG8_STAGE(bufoff, gbase, voff) do { _Pragma("unroll") for (int _i = 0; _i < 2; ++_i) \
        __builtin_amdgcn_global_load_lds((const unsigned*)((const char*)(gbase) + (voff)[_i]), (PG8_LAS unsigned*)(lds + (bufoff) + ldsw + _i * 8192), 16, 0, 0); } while (0)
#define PG8_LDA(dst, b, h) do { _Pragma("unroll") for (int m = 0; m < 4; ++m) _Pragma("unroll") for (int k = 0; k < 2; ++k) dst[m][k] = *(const PG8_LAS bf16x8*)(lds + PG8_SA(b, h) + aoff + m * 2048 + k * 1024); } while (0)
#define PG8_LDB(dst, b, h) do { _Pragma("unroll") for (int n = 0; n < 2; ++n) _Pragma("unroll") for (int k = 0; k < 2; ++k) dst[n][k] = *(const PG8_LAS bf16x8*)(lds + PG8_SB(b, h) + boff + n * 2048 + k * 1024); } while (0)
#define PG8_MMA(ai, bj, At, Bt) do { __builtin_amdgcn_s_setprio(1); _Pragma("unroll") for (int m = 0; m < 4; ++m) _Pragma("unroll") for (int n = 0; n < 2; ++n) _Pragma("unroll") for (int k = 0; k < 2; ++k) \
        acc[ai][bj][m][n] = __builtin_amdgcn_mfma_f32_16x16x32_bf16(Bt[n][k], At[m][k], acc[ai][bj][m][n], 0, 0, 0); __builtin_amdgcn_s_setprio(0); } while (0)
#define PG8_WAIT_V(n) asm volatile("s_waitcnt vmcnt(" #n ")" ::: "memory")
#define PG8_WAIT_L(n) asm volatile("s_waitcnt lgkmcnt(" #n ")" ::: "memory")
#define PG8_BAR __builtin_amdgcn_s_barrier()
#define PG8_SCHED __builtin_amdgcn_sched_barrier(0)
    Unit cur, nxt; int ui = 0;
    if (!S.next(0, cur)) return;
    f32x4 acc[2][2][4][2];
#pragma unroll
    for (int a = 0; a < 2; ++a)
#pragma unroll
        for (int b = 0; b < 2; ++b)
#pragma unroll
            for (int m = 0; m < 4; ++m)
#pragma unroll
                for (int n = 0; n < 2; ++n) acc[a][b][m][n] = (f32x4){0.f, 0.f, 0.f, 0.f};
    bf16x8 At[4][2], B0[2][2], B1[2][2];
    const char* cA = (const char*)g.A + (size_t)cur.pm * tstep + (size_t)cur.ks * sstep; const char* cB = (const char*)g.Bt + (size_t)cur.pn * tstep + (size_t)cur.ks * sstep;
    S.a_ready(cur);
    if constexpr (SP2) {
        PG8_STAGE(PG8_SB(0, 0), cB, voffB); PG8_STAGE(PG8_SB(0, 1), cB + hstep, voffB); PG8_STAGE(PG8_SA(0, 0), cA, voffA); PG8_STAGE(PG8_SA(0, 1), cA + hstep, voffA);
        if (wr == 1) PG8_BAR;
        PG8_WAIT_V(2); PG8_BAR;
        PG8_STAGE(PG8_SB(1, 0), cB + kstep, voffB); PG8_STAGE(PG8_SA(1, 0), cA + kstep, voffA); PG8_STAGE(PG8_SB(1, 1), cB + hstep + kstep, voffB);
        PG8_WAIT_V(6); PG8_BAR;
    } else {
        PG8_STAGE(PG8_SB(0, 0), cB, voffB); PG8_STAGE(PG8_SA(0, 0), cA, voffA); PG8_STAGE(PG8_SB(0, 1), cB + hstep, voffB); PG8_STAGE(PG8_SA(0, 1), cA + hstep, voffA);
        if (wr == 1) PG8_BAR;
        PG8_WAIT_V(4); PG8_BAR;
        PG8_STAGE(PG8_SB(1, 0), cB + kstep, voffB); PG8_STAGE(PG8_SA(1, 0), cA + kstep, voffA); PG8_STAGE(PG8_SB(1, 1), cB + hstep + kstep, voffB);
        PG8_WAIT_V(6); PG8_BAR;
    }
    for (;;) {
        const bool has_next = S.next(ui + 1, nxt);
        const char* nA = has_next ? (const char*)g.A + (size_t)nxt.pm * tstep + (size_t)nxt.ks * sstep : cA; const char* nB = has_next ? (const char*)g.Bt + (size_t)nxt.pn * tstep + (size_t)nxt.ks * sstep : cB;
        const int ntc = cur.nt ? cur.nt : nt;
        for (int t = 0; t < ntc; t += 2) {
            const bool last = (t == ntc - 2);
            const char* a1 = cA + (size_t)(t + 1) * kstep;
            const char* a2 = last ? nA : cA + (size_t)(t + 2) * kstep; const char* b2 = last ? nB : cB + (size_t)(t + 2) * kstep;
            const char* a3 = a2 + kstep; const char* b3 = b2 + kstep;
            if (last && has_next) S.a_ready(nxt);
            if constexpr (SP2) {
            PG8_LDB(B0, 0, 0); PG8_LDB(B1, 0, 1); PG8_SCHED; PG8_LDA(At, 0, 0); PG8_STAGE(PG8_SA(1, 1), a1 + hstep, voffA);
            PG8_WAIT_V(8); PG8_WAIT_L(0); PG8_BAR; PG8_MMA(0, 0, At, B0); PG8_MMA(0, 1, At, B1); PG8_BAR; PG8_SCHED;
            PG8_LDA(At, 0, 1); PG8_STAGE(PG8_SB(0, 0), b2, voffB); PG8_STAGE(PG8_SB(0, 1), b2 + hstep, voffB); PG8_STAGE(PG8_SA(0, 0), a2, voffA);
            PG8_WAIT_V(8); PG8_WAIT_L(0); PG8_BAR; PG8_MMA(1, 0, At, B0); PG8_MMA(1, 1, At, B1); PG8_BAR; PG8_SCHED;
            PG8_LDB(B0, 1, 0); PG8_LDB(B1, 1, 1); PG8_SCHED; PG8_LDA(At, 1, 0); PG8_STAGE(PG8_SA(0, 1), a2 + hstep, voffA);
            PG8_WAIT_V(8); PG8_WAIT_L(0); PG8_BAR; PG8_MMA(0, 0, At, B0); PG8_MMA(0, 1, At, B1); PG8_BAR; PG8_SCHED;
            PG8_LDA(At, 1, 1); PG8_STAGE(PG8_SB(1, 0), b3, voffB); PG8_STAGE(PG8_SB(1, 1), b3 + hstep, voffB); PG8_STAGE(PG8_SA(1, 0), a3, voffA);
            PG8_WAIT_V(8); PG8_WAIT_L(0); PG8_BAR; PG8_MMA(1, 0, At, B0); PG8_MMA(1, 1, At, B1); PG8_BAR; PG8_SCHED;
            } else {
            PG8_LDB(B0, 0, 0); PG8_SCHED; PG8_LDA(At, 0, 0); PG8_STAGE(PG8_SA(1, 1), a1 + hstep, voffA);
            PG8_WAIT_L(8); PG8_BAR; PG8_WAIT_L(0); PG8_MMA(0, 0, At, B0); PG8_BAR; PG8_SCHED;
            PG8_LDB(B1, 0, 1); PG8_STAGE(PG8_SB(0, 0), b2, voffB);
            PG8_BAR; PG8_WAIT_L(0); PG8_MMA(0, 1, At, B1); PG8_BAR;
            PG8_LDA(At, 0, 1); PG8_STAGE(PG8_SA(0, 0), a2, voffA);
            PG8_BAR; PG8_WAIT_L(0); PG8_MMA(1, 0, At, B0); PG8_BAR; PG8_SCHED;
            PG8_STAGE(PG8_SB(0, 1), b2 + hstep, voffB);
            PG8_WAIT_V(6); PG8_BAR; PG8_MMA(1, 1, At, B1); PG8_BAR;
            PG8_LDB(B0, 1, 0); PG8_SCHED; PG8_LDA(At, 1, 0); PG8_STAGE(PG8_SA(0, 1), a2 + hstep, voffA);
            PG8_WAIT_L(8); PG8_BAR; PG8_WAIT_L(0); PG8_MMA(0, 0, At, B0); PG8_BAR; PG8_SCHED;
            PG8_LDB(B1, 1, 1); PG8_STAGE(PG8_SB(1, 0), b3, voffB);
            PG8_BAR; PG8_WAIT_L(0); PG8_MMA(0, 1, At, B1); PG8_BAR;
            PG8_LDA(At, 1, 1); PG8_STAGE(PG8_SA(1, 0), a3, voffA);
            PG8_BAR; PG8_WAIT_L(0); PG8_MMA(1, 0, At, B0); PG8_BAR; PG8_SCHED;
            PG8_STAGE(PG8_SB(1, 1), b3 + hstep, voffB);
            PG8_WAIT_V(6); PG8_BAR; PG8_MMA(1, 1, At, B1); PG8_BAR;
            }
        }
        if constexpr (ALIGN_EPI) { if (wr == 0) PG8_BAR; }
        if constexpr (!Epi::AFTER_DRAIN) { E(acc, cur, wr, wc, fr, fq); S.done(cur); }
        if (!has_next) break;
#pragma unroll
        for (int a = 0; a < 2; ++a)
#pragma unroll
            for (int b = 0; b < 2; ++b)
#pragma unroll
                for (int m = 0; m < 4; ++m)
#pragma unroll
                    for (int n = 0; n < 2; ++n) acc[a][b][m][n] = (f32x4){0.f, 0.f, 0.f, 0.f};
        cur = nxt; cA = nA; cB = nB; ++ui;
        if constexpr (ALIGN_EPI) { if (wr == 1) PG8_BAR; }
    }
    PG8_WAIT_V(0);
    if constexpr (!ALIGN_EPI) { if (wr == 0) PG8_BAR; }
    PG8_BAR;
    if constexpr (Epi::AFTER_DRAIN) { E.fused(acc, cur, wr, wc, fr, fq, lds, wid, lane); S.done(cur); }
#undef PG8_SA
#undef PG8_SB
#undef PG8_STAGE
#undef PG8_LDA
#undef PG8_LDB
#undef PG8_MMA
#undef PG8_WAIT_V
#undef PG8_WAIT_L
#undef PG8_BAR
#undef PG8_SCHED
}
}

namespace mk {
#define LAS __attribute__((address_space(3)))
using pg8::bf16_t; using pg8::f32x4; using pg8::u32x4; using pg8::Unit; using pg8::cvt_pk_bf16; using pg8::bf16x8;
typedef unsigned u32x2 __attribute__((ext_vector_type(2)));
typedef float f32x16 __attribute__((ext_vector_type(16)));
typedef unsigned long long u64;

constexpr int MP = 16384, MS = 512, MT = MP + MS, D = 1024, FF = 2816, DIN = 3840, DPOOL = 512;
constexpr float EPS = 1e-6f, LOG2E = 1.4426950408889634f, QSCALE = 0.125f * 1.4426950408889634f;
constexpr size_t OFF_Y = 0, OFF_POOLP = (size_t)MT * D, OFF_KP = OFF_POOLP + 4 * 15 * 512, OFF_VP = OFF_KP + 4 * 128 * 128,
                 OFF_POOLS = OFF_VP + 4 * 128 * 128, OFF_KS = OFF_POOLS + 16 * 15 * 512, OFF_VS = OFF_KS + 16 * 128 * 128, OUT_TOTAL = OFF_VS + 16 * 128 * 128;
constexpr size_t MiB = 1u << 20;
constexpr size_t WS_BC = 0, WS_BCP = 64 * 1024, WS_BAR = 128 * 1024, WS_BAR_BYTES = 16 * 1024, WS_SS = 1 * MiB;
constexpr size_t WS_W1 = 3 * MiB, WS_W3 = 14 * MiB, WS_W2 = 25 * MiB, WS_W4 = WS_W2 + 11 * MiB / 2, WS_WIN = 36 * MiB, WS_WC = WS_WIN + 15 * MiB / 2,
                 WS_WAP = WS_WC + 1 * MiB, WS_WO = WS_WAP + 2 * MiB;
constexpr size_t WS_XB = 49 * MiB;
constexpr size_t WS_ACT = 82 * MiB;
constexpr size_t WS_GATES = WS_ACT, WS_POOLED = WS_GATES + 66 * MiB, WS_KB = WS_POOLED + 33 * MiB / 2, WS_VB = WS_KB + (size_t)MT * 128 * 2;
constexpr size_t WS_R = 173 * MiB;
constexpr size_t WS_U = WS_R, WS_Q = WS_R + 33 * MiB, WS_T = WS_R, WS_MIX = WS_R + 33 * MiB, WS_SLAB5A = WS_R + 66 * MiB, WS_SLAB5B = WS_SLAB5A + 4 * MiB, WS_END = WS_SLAB5B + 8 * MiB;
static_assert(WS_VB + (size_t)MT * 128 * 2 <= WS_ACT + (size_t)MT * FF * 2 && WS_ACT + (size_t)MT * FF * 2 <= WS_R && WS_WO + 2 * MiB <= WS_XB && WS_END <= 256 * MiB, "ws map");
static_assert(WS_SS + (size_t)MT * 16 * 4 <= WS_W1, "ss");

__device__ __forceinline__ float sigm(float x) { return __builtin_amdgcn_rcpf(1.0f + __builtin_amdgcn_exp2f(-x * LOG2E)); }
__device__ __forceinline__ float bflo(unsigned w) { return __builtin_bit_cast(float, w << 16); }
__device__ __forceinline__ float bfhi(unsigned w) { return __builtin_bit_cast(float, w & 0xffff0000u); }
__device__ __forceinline__ float rstd_of(const float* ss, int r) {
    const f32x4* p = (const f32x4*)(ss + (size_t)r * 16);
    const f32x4 s = (p[0] + p[1]) + (p[2] + p[3]);
    return rsqrtf(((s[0] + s[1]) + (s[2] + s[3])) * (1.0f / 1024.0f) + EPS);
}
__device__ __forceinline__ float wave_sum(float v) {
#pragma unroll
    for (int o = 1; o < 64; o <<= 1) v += __shfl_xor(v, o);
    return v;
}


template <bool PERM> __device__ __forceinline__ void slab_store(float* slab, const f32x4 (&acc)[2][2][4][2], const Unit& u, int wr, int wc, int fr, int fq) {
    float* base = slab + ((size_t)u.ks * MS + (u.pm * 256 - MP + wr * 64 + fr)) * D + u.pn * 256 + wc * 32 + (PERM ? fq * 8 : fq * 4);
#pragma unroll
    for (int ai = 0; ai < 2; ++ai)
#pragma unroll
        for (int m = 0; m < 4; ++m)
#pragma unroll
            for (int bj = 0; bj < 2; ++bj)
#pragma unroll
                for (int n = 0; n < 2; ++n) *(f32x4*)(base + (ai * 128 + m * 16) * D + bj * 128 + (PERM ? n * 4 : n * 16)) = acc[ai][bj][m][n];
}


template <bool USE_RS> struct EpiSwiglu {
    static constexpr bool PERM = true, AFTER_DRAIN = false;
    bf16_t* O; const LAS float* lrs;
    __device__ __forceinline__ void operator()(const f32x4 (&acc)[2][2][4][2], const Unit& u, int wr, int wc, int fr, int fq) const {
#pragma unroll
        for (int ai = 0; ai < 2; ++ai)
#pragma unroll
            for (int m = 0; m < 4; ++m) {
                const int r = u.pm * 256 + ai * 128 + wr * 64 + m * 16 + fr;
                const float rs = USE_RS ? lrs[u.ks * 256 + ai * 128 + wr * 64 + m * 16 + fr] : 1.0f;
                u32x4 w;
#pragma unroll
                for (int n = 0; n < 2; ++n) {
                    const f32x4 g = acc[ai][0][m][n] * rs, up = acc[ai][1][m][n] * rs;
                    float o[4];
#pragma unroll
                    for (int j = 0; j < 4; ++j) o[j] = g[j] * sigm(g[j]) * up[j];
                    w[2 * n] = cvt_pk_bf16(o[0], o[1]); w[2 * n + 1] = cvt_pk_bf16(o[2], o[3]);
                }
                *(u32x4*)(O + (size_t)r * FF + u.pn * 128 + wc * 32 + fq * 8) = w;
            }
    }
};

template <int MODE> struct EpiResid {
    static constexpr bool PERM = false, AFTER_DRAIN = false;
    const float* resA; const float* resB; float* out; bf16_t* ob; float* ss; float alpha; float* slab;
    __device__ __forceinline__ void operator()(const f32x4 (&acc)[2][2][4][2], const Unit& u, int wr, int wc, int fr, int fq) const {
        if (u.nt) { slab_store<false>(slab, acc, u, wr, wc, fr, fq); return; }
#pragma unroll
        for (int ai = 0; ai < 2; ++ai)
#pragma unroll
            for (int m = 0; m < 4; ++m) {
                const int r = u.pm * 256 + ai * 128 + wr * 64 + m * 16 + fr;
                const float* rp = (r < MP) ? resA + (size_t)r * D : resB + (size_t)(r - MP) * D;
                float sq = 0.f;
#pragma unroll
                for (int bj = 0; bj < 2; ++bj)
#pragma unroll
                    for (int n = 0; n < 2; ++n) {
                        const int c = u.pn * 256 + bj * 128 + wc * 32 + n * 16 + fq * 4;
                        f32x4 v;
                        if (MODE == 0) v = *(const f32x4*)(rp + c);
                        else { const u32x2 b = *(const u32x2*)(ob + (size_t)r * D + c); v = (f32x4){bflo(b.x), bfhi(b.x), bflo(b.y), bfhi(b.y)}; }
                        const f32x4 o = v + acc[ai][bj][m][n] * alpha;
                        if (MODE == 2) *(f32x4*)(out + (size_t)r * D + c) = o;
                        else { u32x2 w; w.x = cvt_pk_bf16(o[0], o[1]); w.y = cvt_pk_bf16(o[2], o[3]); *(u32x2*)(ob + (size_t)r * D + c) = w; }
                        sq += (o[0] * o[0] + o[1] * o[1]) + (o[2] * o[2] + o[3] * o[3]);
                    }
                if (MODE != 2) { sq += __shfl_xor(sq, 16); sq += __shfl_xor(sq, 32); if (fq == 0) ss[(size_t)r * 16 + u.pn * 4 + wc] = sq; }
            }
    }
};

constexpr int LDS_T2_OFF = 7 * 256;
struct EpiWin {
    static constexpr bool PERM = true, AFTER_DRAIN = false;
    const LAS float* lrs; float* uo; bf16_t* q; bf16_t* kb; bf16_t* vb; bf16_t* gates; const float* bgate; const float* qg; const float* kg; float* out;
    __device__ __forceinline__ void operator()(const f32x4 (&acc)[2][2][4][2], const Unit& u, int wr, int wc, int fr, int fq) const {
        const int pn = u.pn;
        if (pn < 2) {
#pragma unroll
            for (int ai = 0; ai < 2; ++ai)
#pragma unroll
                for (int m = 0; m < 4; ++m) {
                    const int r = u.pm * 256 + ai * 128 + wr * 64 + m * 16 + fr;
                    const float rs = lrs[u.ks * 256 + ai * 128 + wr * 64 + m * 16 + fr];
                    float* o2 = nullptr;
                    if (r < MP) { const int s = r & 4095; if (s >= 4081) o2 = out + OFF_POOLP + (size_t)((r >> 12) * 15 + (s - 4081)) * 512; }
                    else { const int rr = r - MP, t = rr & 31; if (t >= 17) o2 = out + OFF_POOLS + (size_t)((rr >> 5) * 15 + (t - 17)) * 512; }
#pragma unroll
                    for (int bj = 0; bj < 2; ++bj)
#pragma unroll
                        for (int n = 0; n < 2; ++n) {
                            const int c = pn * 256 + bj * 128 + wc * 32 + fq * 8 + n * 4;
                            const f32x4 v = acc[ai][bj][m][n] * rs;
                            *(f32x4*)(uo + (size_t)r * 512 + c) = v;
                            if (o2) *(f32x4*)(o2 + c) = v;
                        }
                }
        } else if (pn < 7) {
            const bool is_q = pn < 6, is_v = (!is_q) && wc >= 2;
            const float* gp = is_q ? qg : kg;
            f32x4 gn[2][2];
#pragma unroll
            for (int bj = 0; bj < 2; ++bj)
#pragma unroll
                for (int n = 0; n < 2; ++n) { gn[bj][n] = *(const f32x4*)(gp + bj * 32 + fq * 8 + n * 4); if (is_q) gn[bj][n] = gn[bj][n] * QSCALE; }
#pragma unroll
            for (int ai = 0; ai < 2; ++ai)
#pragma unroll
                for (int m = 0; m < 4; ++m) {
                    const int r = u.pm * 256 + ai * 128 + wr * 64 + m * 16 + fr;
                    const float rs = lrs[u.ks * 256 + ai * 128 + wr * 64 + m * 16 + fr];
                    f32x4 v[2][2]; float sq = 0.f;
#pragma unroll
                    for (int bj = 0; bj < 2; ++bj)
#pragma unroll
                        for (int n = 0; n < 2; ++n) { v[bj][n] = acc[ai][bj][m][n] * rs; const f32x4 t = v[bj][n]; sq += (t[0] * t[0] + t[1] * t[1]) + (t[2] * t[2] + t[3] * t[3]); }
                    sq += __shfl_xor(sq, 16); sq += __shfl_xor(sq, 32);
                    const float r2 = rsqrtf(sq * (1.0f / 64.0f) + EPS);
                    if (!is_v) {
#pragma unroll
                        for (int bj = 0; bj < 2; ++bj)
#pragma unroll
                            for (int n = 0; n < 2; ++n) v[bj][n] = v[bj][n] * r2 * gn[bj][n];
                    }
                    bf16_t* dst; float* o2 = nullptr;
                    if (is_q) dst = q + (size_t)r * 1024 + ((pn - 2) * 4 + wc) * 64;
                    else {
                        const int kvh = wc & 1;
                        dst = (is_v ? vb : kb) + (size_t)r * 128 + kvh * 64;
                        const size_t ob = is_v ? OFF_VP : OFF_KP, obs = is_v ? OFF_VS : OFF_KS;
                        if (r < MP) { const int s = r & 4095; if (s >= 3968) o2 = out + ob + (size_t)(((r >> 12) * 128 + (s - 3968)) * 2 + kvh) * 64; }
                        else { const int rr = r - MP; o2 = out + obs + (size_t)(((rr >> 5) * 128 + 96 + (rr & 31)) * 2 + kvh) * 64; }
                    }
#pragma unroll
                    for (int bj = 0; bj < 2; ++bj) {
                        u32x4 w; w.x = cvt_pk_bf16(v[bj][0][0], v[bj][0][1]); w.y = cvt_pk_bf16(v[bj][0][2], v[bj][0][3]);
                        w.z = cvt_pk_bf16(v[bj][1][0], v[bj][1][1]); w.w = cvt_pk_bf16(v[bj][1][2], v[bj][1][3]);
                        *(u32x4*)(dst + bj * 32 + fq * 8) = w;
                        if (o2) { *(f32x4*)(o2 + bj * 32 + fq * 8) = v[bj][0]; *(f32x4*)(o2 + bj * 32 + fq * 8 + 4) = v[bj][1]; }
                    }
                }
        } else {
            const int gc0 = (pn - 7) * 256 + wc * 32 + fq * 8;
            f32x4 bv[2][2];
#pragma unroll
            for (int bj = 0; bj < 2; ++bj)
#pragma unroll
                for (int n = 0; n < 2; ++n) bv[bj][n] = *(const LAS f32x4*)(lrs + LDS_T2_OFF + u.ks * 256 + wc * 32 + fq * 8 + bj * 128 + n * 4);
#pragma unroll
            for (int ai = 0; ai < 2; ++ai)
#pragma unroll
                for (int m = 0; m < 4; ++m) {
                    const int r = u.pm * 256 + ai * 128 + wr * 64 + m * 16 + fr;
                    const float rs = lrs[u.ks * 256 + ai * 128 + wr * 64 + m * 16 + fr];
#pragma unroll
                    for (int bj = 0; bj < 2; ++bj) {
                        u32x4 w;
#pragma unroll
                        for (int n = 0; n < 2; ++n) {
                            const f32x4 z = acc[ai][bj][m][n] * rs + bv[bj][n];
                            w[2 * n] = cvt_pk_bf16(sigm(z[0]), sigm(z[1])); w[2 * n + 1] = cvt_pk_bf16(sigm(z[2]), sigm(z[3]));
                        }
                        *(u32x4*)(gates + (size_t)r * 2048 + gc0 + bj * 128) = w;
                    }
                }
        }
    }
};


struct EpiMix1 {
    static constexpr bool PERM = true, AFTER_DRAIN = false;
    const bf16_t* gates; const float* bc; bf16_t* t; float* slab;
    __device__ __forceinline__ void operator()(const f32x4 (&acc)[2][2][4][2], const Unit& u, int wr, int wc, int fr, int fq) const {
        if (u.nt) { slab_store<true>(slab, acc, u, wr, wc, fr, fq); return; }
        const int c0 = u.pn * 256 + wc * 32 + fq * 8;
        f32x4 bv[2][2];
#pragma unroll
        for (int bj = 0; bj < 2; ++bj)
#pragma unroll
            for (int n = 0; n < 2; ++n) bv[bj][n] = *(const f32x4*)(bc + c0 + bj * 128 + n * 4);
#pragma unroll
        for (int ai = 0; ai < 2; ++ai)
#pragma unroll
            for (int m = 0; m < 4; ++m) {
                const int r = u.pm * 256 + ai * 128 + wr * 64 + m * 16 + fr;
#pragma unroll
                for (int bj = 0; bj < 2; ++bj) {
                    const int c = c0 + bj * 128;
                    const u32x4 g = *(const u32x4*)(gates + (size_t)r * 2048 + c);
                    const f32x4 a0 = acc[ai][bj][m][0] + bv[bj][0], a1 = acc[ai][bj][m][1] + bv[bj][1];
                    u32x4 w;
                    w.x = cvt_pk_bf16(bflo(g.x) * a0[0], bfhi(g.x) * a0[1]); w.y = cvt_pk_bf16(bflo(g.y) * a0[2], bfhi(g.y) * a0[3]);
                    w.z = cvt_pk_bf16(bflo(g.z) * a1[0], bfhi(g.z) * a1[1]); w.w = cvt_pk_bf16(bflo(g.w) * a1[2], bfhi(g.w) * a1[3]);
                    *(u32x4*)(t + (size_t)r * 1024 + c) = w;
                }
            }
    }
};
struct EpiMix2 {
    static constexpr bool PERM = true, AFTER_DRAIN = false;
    const bf16_t* gates; const bf16_t* t; bf16_t* mix; float* slab;
    __device__ __forceinline__ void operator()(const f32x4 (&acc)[2][2][4][2], const Unit& u, int wr, int wc, int fr, int fq) const {
        if (u.nt) { slab_store<true>(slab, acc, u, wr, wc, fr, fq); return; }
        const int c0 = u.pn * 256 + wc * 32 + fq * 8;
#pragma unroll
        for (int ai = 0; ai < 2; ++ai)
#pragma unroll
            for (int m = 0; m < 4; ++m) {
                const int r = u.pm * 256 + ai * 128 + wr * 64 + m * 16 + fr;
#pragma unroll
                for (int bj = 0; bj < 2; ++bj) {
                    const int c = c0 + bj * 128;
                    const u32x4 g = *(const u32x4*)(gates + (size_t)r * 2048 + 1024 + c);
                    const u32x4 tv = *(const u32x4*)(t + (size_t)r * 1024 + c);
                    const f32x4 a0 = acc[ai][bj][m][0], a1 = acc[ai][bj][m][1];
                    u32x4 w;
                    w.x = cvt_pk_bf16(bflo(tv.x) + bflo(g.x) * a0[0], bfhi(tv.x) + bfhi(g.x) * a0[1]); w.y = cvt_pk_bf16(bflo(tv.y) + bflo(g.y) * a0[2], bfhi(tv.y) + bfhi(g.y) * a0[3]);
                    w.z = cvt_pk_bf16(bflo(tv.z) + bflo(g.z) * a1[0], bfhi(tv.z) + bfhi(g.z) * a1[1]); w.w = cvt_pk_bf16(bflo(tv.w) + bflo(g.w) * a1[2], bfhi(tv.w) + bfhi(g.w) * a1[3]);
                    *(u32x4*)(mix + (size_t)r * 1024 + c) = w;
                }
            }
    }
};


template <int S> struct ComboOrder : pg8::StaticOrder {
    int soff;
    __device__ bool next(int i, Unit& u) const {
        const int L = i * G + c;
        if (L < nwg) return pg8::StaticOrder::next(i, u);
        const int i0 = (c < nwg) ? (nwg - c + G - 1) / G : 0;
        const int j = (c - soff + G) % G + (i - i0) * G;
        if (j >= 8 * S) return false;
        const int t = j / S; u.pm = MP / 256 + (t >> 2); u.pn = t & 3; u.ks = j - t * S; u.nt = 4; return true;
    }
};
template <int S> __device__ __forceinline__ f32x4 slab_sum(const float* slab, int rl, int c) {
    f32x4 v[S];
#pragma unroll
    for (int k = 0; k < S; ++k) v[k] = *(const f32x4*)(slab + ((size_t)k * MS + rl) * D + c);
    f32x4 s = v[0];
#pragma unroll
    for (int k = 1; k < S; ++k) s += v[k];
    return s;
}
template <int S, int MODE> __device__ __forceinline__ void reduce_resid(const float* slab, const float* res_base  , float* out  , bf16_t* ob, float* ss, float alpha, int lane, int wave) {
    for (int it = blockIdx.x * 8 + wave; it < MS * 4; it += gridDim.x * 8) {
        const int rl = it >> 2, pn = it & 3, c = pn * 256 + lane * 4;
        f32x4 v;
        if (MODE == 0) v = *(const f32x4*)(res_base + (size_t)rl * D + c);
        else { const u32x2 b = *(const u32x2*)(ob + (size_t)(MP + rl) * D + c); v = (f32x4){bflo(b.x), bfhi(b.x), bflo(b.y), bfhi(b.y)}; }
        const f32x4 o = v + slab_sum<S>(slab, rl, c) * alpha;
        if (MODE == 2) *(f32x4*)(out + (size_t)(MP + rl) * D + c) = o;
        else { u32x2 w; w.x = cvt_pk_bf16(o[0], o[1]); w.y = cvt_pk_bf16(o[2], o[3]); *(u32x2*)(ob + (size_t)(MP + rl) * D + c) = w;
            float sq = (o[0] * o[0] + o[1] * o[1]) + (o[2] * o[2] + o[3] * o[3]);
            sq += __shfl_xor(sq, 1); sq += __shfl_xor(sq, 2); sq += __shfl_xor(sq, 4); sq += __shfl_xor(sq, 32);
            if (lane < 32 && (lane & 7) == 0) ss[(size_t)(MP + rl) * 16 + pn * 4 + (lane >> 3)] = sq; }
    }
}
template <int S1, int S2> __device__ __forceinline__ void reduce_mix(const float* slab1, const float* slab2, const bf16_t* gates, const float* bc, bf16_t* mix, int lane, int wave) {
    for (int it = blockIdx.x * 8 + wave; it < MS * 4; it += gridDim.x * 8) {
        const int rl = it >> 2, pn = it & 3, c = pn * 256 + lane * 4;
        const f32x4 a1 = slab_sum<S1>(slab1, rl, c) + *(const f32x4*)(bc + c), a2 = slab_sum<S2>(slab2, rl, c);
        const u32x2 ga = *(const u32x2*)(gates + (size_t)(MP + rl) * 2048 + c), gb = *(const u32x2*)(gates + (size_t)(MP + rl) * 2048 + 1024 + c);
        u32x2 w; w.x = cvt_pk_bf16(bflo(ga.x) * a1[0] + bflo(gb.x) * a2[0], bfhi(ga.x) * a1[1] + bfhi(gb.x) * a2[1]);
        w.y = cvt_pk_bf16(bflo(ga.y) * a1[2] + bflo(gb.y) * a2[2], bfhi(ga.y) * a1[3] + bfhi(gb.y) * a2[3]);
        *(u32x2*)(mix + (size_t)(MP + rl) * D + c) = w;
    }
}

__device__ __forceinline__ unsigned f2bf(float f) { unsigned u = __builtin_bit_cast(unsigned, f); return (u + 0x7fffu + ((u >> 16) & 1u)) >> 16; }
__device__ __forceinline__ unsigned pk2(float lo, float hi) { return f2bf(lo) | (f2bf(hi) << 16); }

template <int MAP> __device__ __forceinline__ int rowmap(int n) {
    if (MAP == 1) { if (n < FF) return ((n >> 7) << 8) + (n & 127); n -= FF; return ((n >> 7) << 8) + 128 + (n & 127); }
    if (MAP == 2) { if (n >= 512 && n < 1792) { const int t = n & ~255, lc = n & 255, hh = lc >> 6, d = lc & 63; return t + ((d >> 5) << 7) + (hh << 5) + (d & 31); } return n; }
    return n;
}
template <int MAP> __device__ __forceinline__ void transpose_item(const float* W, int K, int N, const float* gain, bf16_t* WT, LAS float* scr, int item, int lane) {
    const int nblk = N / 32, kb = item / nblk, nb = item % nblk, k0 = 64 * kb, n0 = 32 * nb;
#pragma unroll
    for (int i = 0; i < 8; ++i) { const int kk = 8 * i + (lane >> 3);
        f32x4 w = *(const f32x4*)(W + (size_t)(k0 + kk) * N + n0 + (lane & 7) * 4); if (gain) w = w * gain[k0 + kk];
        LAS float* d = scr + kk * 33 + (lane & 7) * 4; d[0] = w[0]; d[1] = w[1]; d[2] = w[2]; d[3] = w[3]; }
    asm volatile("s_waitcnt lgkmcnt(0)" ::: "memory");
    const int c = lane & 7;
#pragma unroll
    for (int j = 0; j < 4; ++j) { const int n = (lane >> 3) + 8 * j; const LAS float* s = scr + (8 * c) * 33 + n;
        u32x4 o; o.x = pk2(s[0 * 33], s[1 * 33]); o.y = pk2(s[2 * 33], s[3 * 33]); o.z = pk2(s[4 * 33], s[5 * 33]); o.w = pk2(s[6 * 33], s[7 * 33]);
        *(u32x4*)(WT + (size_t)rowmap<MAP>(n0 + n) * K + k0 + 8 * c) = o; }
    asm volatile("s_waitcnt lgkmcnt(0)" ::: "memory");
}

struct Args { const float* in[23]; float* out; unsigned char* ws; };

template <int PART> __device__ __forceinline__ void prologue(const Args& a, LAS unsigned char* lds, int tid, int lane, int wave, int gw, int NGW) {
    unsigned char* ws = a.ws;
    LAS float* scr = (LAS float*)(lds + wave * 16384);
    constexpr int I_UP = (D / 64) * (2 * FF / 32), I_DN = (FF / 64) * (D / 32), I_IN = (D / 64) * (DIN / 32), I_SQ = (D / 64) * (D / 32);
    if (PART == 0) {
        for (int it = gw; it < I_UP; it += NGW) transpose_item<1>(a.in[6], D, 2 * FF, a.in[5], (bf16_t*)(ws + WS_W1), scr, it, lane);
    } else if (PART == 2) {
        for (int it = gw; it < I_DN; it += NGW) transpose_item<0>(a.in[7], FF, D, nullptr, (bf16_t*)(ws + WS_W2), scr, it, lane);
    } else if (PART == 1) {
        for (int it = gw; it < I_IN; it += NGW) transpose_item<2>(a.in[9], D, DIN, a.in[8], (bf16_t*)(ws + WS_WIN), scr, it, lane);
    } else if (PART == 3) {
        for (int it = gw; it < 2 * I_SQ; it += NGW) { if (it < I_SQ) transpose_item<0>(a.in[18], D, D, nullptr, (bf16_t*)(ws + WS_WAP), scr, it, lane); else transpose_item<0>(a.in[19], D, D, nullptr, (bf16_t*)(ws + WS_WO), scr, it - I_SQ, lane); }
    } else if (PART == 4) {
        for (int it = gw; it < I_UP; it += NGW) transpose_item<1>(a.in[21], D, 2 * FF, a.in[20], (bf16_t*)(ws + WS_W3), scr, it, lane);
    } else if (PART == 5) {
        for (int it = gw; it < I_DN; it += NGW) transpose_item<0>(a.in[22], FF, D, nullptr, (bf16_t*)(ws + WS_W4), scr, it, lane);
    }
    if (PART == 1) {
        const float* pw = a.in[11]; const float* psc = a.in[13]; const float* Wpp = a.in[17]; bf16_t* WcT = (bf16_t*)(ws + WS_WC);
        for (int it = gw; it < 512 * 4; it += NGW) {
            const int c = it >> 2, n = (it & 3) * 256 + lane * 4, g = c >> 7;
            f32x4 s = (f32x4){0.f, 0.f, 0.f, 0.f};
#pragma unroll 8
            for (int d = 0; d < 128; ++d) { const float coef = pw[(size_t)c * 128 + d] * psc[g * 128 + d]; s += *(const f32x4*)(Wpp + (size_t)(g * 128 + d) * D + n) * coef; }
#pragma unroll
            for (int j = 0; j < 4; ++j) WcT[(size_t)(n + j) * 512 + c] = (bf16_t)f2bf(s[j]);
        }
        const float* pb = a.in[12]; float* bcp = (float*)(ws + WS_BCP);
        for (int it = gw; it < 64; it += NGW) {
            const int kb = it >> 2, n = (it & 3) * 256 + lane * 4;
            f32x4 s = (f32x4){0.f, 0.f, 0.f, 0.f};
#pragma unroll 8
            for (int d = kb * 32; d < kb * 32 + 32; ++d) s += *(const f32x4*)(Wpp + (size_t)d * D + n) * (pb[d] * psc[d]);
            *(f32x4*)(bcp + kb * 1024 + n) = s;
        }
    }
    if (PART == 0) {
        bf16_t* xb = (bf16_t*)(ws + WS_XB); float* ss = (float*)(ws + WS_SS);
        for (int m = gw; m < MT; m += NGW) {
            const float* xr = (m < MP) ? a.in[0] + (size_t)m * D : a.in[1] + (size_t)(m - MP) * D;
            f32x4 v[4]; float s = 0.f;
#pragma unroll
            for (int j = 0; j < 4; ++j) { v[j] = *(const f32x4*)(xr + lane * 4 + 256 * j); s += (v[j][0] * v[j][0] + v[j][1] * v[j][1]) + (v[j][2] * v[j][2] + v[j][3] * v[j][3]); }
            s = wave_sum(s);
            const float rn = rsqrtf(s * (1.0f / 1024.0f) + EPS);
#pragma unroll
            for (int j = 0; j < 4; ++j) { const f32x4 t = v[j] * rn; u32x2 w; w.x = cvt_pk_bf16(t[0], t[1]); w.y = cvt_pk_bf16(t[2], t[3]); *(u32x2*)(xb + (size_t)m * D + lane * 4 + 256 * j) = w; }
            if (lane < 16) ss[(size_t)m * 16 + lane] = (lane == 0) ? s : 0.f;
        }
    }
    if (PART == 0) {
        const int gt = blockIdx.x * 512 + tid, NT = gridDim.x * 512;
        for (int i = gt; i < 2 * 16 * 96 * 32; i += NT) {
            const int which = i / (16 * 96 * 32), j = i % (16 * 96 * 32), b = j / (96 * 32), rem = j % (96 * 32);
            const float* src = a.in[3 + which] + (size_t)(b * 128 + 32) * 128 + rem * 4;
            float* dst = a.out + (which ? OFF_VS : OFF_KS) + (size_t)(b * 128) * 128 + rem * 4;
            *(f32x4*)dst = *(const f32x4*)src;
        }
    }
}

constexpr int KS_STRIDE = 144, VT_STRIDE = 400, LDS_KS = 0, LDS_VT = 192 * KS_STRIDE;
__device__ __forceinline__ int vt_pos(int key) { const int k = key & 15; return (key & ~15) + ((k >> 2) & 1) * 8 + (k & 3) + 4 * (k >> 3); }
__device__ __forceinline__ void attn_qblock(const bf16x8 (&qf)[4], int qrow0, int head, int nkb, const LAS unsigned char* Ks, const LAS unsigned char* VT, float sink2, bf16_t* yb, int lane) {
    const int qr = lane & 31, h = lane >> 5;
    f32x16 S[6];
#pragma unroll
    for (int kb = 0; kb < 6; ++kb) {
#pragma unroll
        for (int i = 0; i < 16; ++i) S[kb][i] = 0.f;
        if (kb < nkb) {
            const LAS unsigned char* kp = Ks + (kb * 32 + qr) * KS_STRIDE + 16 * h;
#pragma unroll
            for (int s = 0; s < 4; ++s) { const bf16x8 ka = *(const LAS bf16x8*)(kp + 32 * s); S[kb] = __builtin_amdgcn_mfma_f32_32x32x16_bf16(ka, qf[s], S[kb], 0, 0, 0); }
        }
    }
    float mx = sink2;
#pragma unroll
    for (int kb = 0; kb < 6; ++kb) if (kb < nkb) {
#pragma unroll
        for (int i = 0; i < 16; ++i) mx = fmaxf(mx, S[kb][i]);
    }
    mx = fmaxf(mx, __shfl_xor(mx, 32));
    float sum = 0.f;
    bf16x8 P[6][2];
#pragma unroll
    for (int kb = 0; kb < 6; ++kb) {
        if (kb < nkb) {
#pragma unroll
            for (int i = 0; i < 16; ++i) { const float p = __builtin_amdgcn_exp2f(S[kb][i] - mx); S[kb][i] = p; sum += p; }
        }
#pragma unroll
        for (int s = 0; s < 2; ++s) {
            u32x4 w; w.x = cvt_pk_bf16(S[kb][8 * s + 0], S[kb][8 * s + 1]); w.y = cvt_pk_bf16(S[kb][8 * s + 2], S[kb][8 * s + 3]);
            w.z = cvt_pk_bf16(S[kb][8 * s + 4], S[kb][8 * s + 5]); w.w = cvt_pk_bf16(S[kb][8 * s + 6], S[kb][8 * s + 7]);
            P[kb][s] = __builtin_bit_cast(bf16x8, w);
        }
    }
    sum += __shfl_xor(sum, 32);
    const float inv = 1.0f / (sum + __builtin_amdgcn_exp2f(sink2 - mx));
    f32x16 O[2];
#pragma unroll
    for (int db = 0; db < 2; ++db)
#pragma unroll
        for (int i = 0; i < 16; ++i) O[db][i] = 0.f;
#pragma unroll
    for (int kb = 0; kb < 6; ++kb) if (kb < nkb) {
#pragma unroll
        for (int s = 0; s < 2; ++s)
#pragma unroll
            for (int db = 0; db < 2; ++db) {
                const bf16x8 va = *(const LAS bf16x8*)(VT + (db * 32 + qr) * VT_STRIDE + (kb * 32 + 16 * s + 8 * h) * 2);
                O[db] = __builtin_amdgcn_mfma_f32_32x32x16_bf16(va, P[kb][s], O[db], 0, 0, 0);
            }
    }
    bf16_t* op = yb + (size_t)(qrow0 + qr) * 1024 + head * 64 + 4 * h;
#pragma unroll
    for (int db = 0; db < 2; ++db)
#pragma unroll
        for (int g = 0; g < 4; ++g) {
            u32x2 w; w.x = cvt_pk_bf16(O[db][4 * g + 0] * inv, O[db][4 * g + 1] * inv); w.y = cvt_pk_bf16(O[db][4 * g + 2] * inv, O[db][4 * g + 3] * inv);
            *(u32x2*)(op + db * 32 + 8 * g) = w;
        }
}

template <int W> __device__ __forceinline__ void pool_chunk(const float* u, const float* hist, bf16_t* pooled, int r0, int c) {
    const bool samp = r0 >= MP;
    const int s0 = samp ? ((r0 - MP) & 31) : (r0 & 4095);
    const float* hrow = hist + (size_t)(samp ? ((r0 - MP) >> 5) : 0) * 15 * 512 + c;
    f32x4 v[31];
#pragma unroll
    for (int i = 16 - W; i < 31; ++i) {
        const int sp = s0 - 15 + i;
        if (sp >= 0) v[i] = *(const f32x4*)(u + (size_t)(r0 - 15 + i) * 512 + c);
        else if (samp) v[i] = *(const f32x4*)(hrow + (15 + sp) * 512);
        else v[i] = (f32x4){0.f, 0.f, 0.f, 0.f};
    }
    f32x4 sum = (f32x4){0.f, 0.f, 0.f, 0.f};
#pragma unroll
    for (int i = 16 - W; i <= 15; ++i) sum += v[i];
#pragma unroll
    for (int k = 0; k < 16; ++k) {
        if (k) sum += v[15 + k] - v[15 + k - W];
        const int have = s0 + k + 1; const float cnt = samp ? (float)W : (float)(have < W ? have : W);
        const f32x4 o = sum * (1.0f / cnt) - v[15 + k];
        u32x2 wv; wv.x = cvt_pk_bf16(o[0], o[1]); wv.y = cvt_pk_bf16(o[2], o[3]);
        *(u32x2*)(pooled + (size_t)(r0 + k) * 512 + c) = wv;
    }
}

__device__ __forceinline__ void attn_pool_phase(const Args& a, LAS unsigned char* lds, int tid, int lane, int wave) {
    unsigned char* ws = a.ws;
    const bf16_t* q = (const bf16_t*)(ws + WS_Q); const bf16_t* kbuf = (const bf16_t*)(ws + WS_KB); const bf16_t* vbuf = (const bf16_t*)(ws + WS_VB);
    bf16_t* yb = (bf16_t*)a.out;
    LAS unsigned char* Ks = lds + LDS_KS; LAS unsigned char* VT = lds + LDS_VT;
    const float* sinks = a.in[16];
    { const int gt = blockIdx.x * 512 + tid; if (gt < 1024) { const float* bcp = (const float*)(ws + WS_BCP); float s = 0.f;
#pragma unroll
        for (int k = 0; k < 16; ++k) s += bcp[k * 1024 + gt]; ((float*)(ws + WS_BC))[gt] = s; } }
    for (int unit = blockIdx.x; unit < 544; unit += gridDim.x) {
        int nkeys, kvh, qrow0;
        if (unit < 512) { kvh = unit & 1; qrow0 = (unit >> 7) * 4096 + ((unit >> 1) & 63) * 64; } else { kvh = (unit - 512) & 1; qrow0 = MP + ((unit - 512) >> 1) * 32; }
        const int head = kvh * 8 + wave;
        __syncthreads();
        if (unit < 512) {
            const int c = (unit >> 1) & 63, b = unit >> 7; const int c0 = c < 2 ? 0 : c - 2;
            nkeys = 64 * (c - c0 + 1); const int krow0 = b * 4096 + c0 * 64;
            const int key0 = tid >> 3, ch = tid & 7;
            u32x4 kv[3], vv[3];
#pragma unroll
            for (int i = 0; i < 3; ++i) if (i * 64 < nkeys) { const size_t off = (size_t)(krow0 + i * 64 + key0) * 128 + kvh * 64 + ch * 8; kv[i] = *(const u32x4*)(kbuf + off); vv[i] = *(const u32x4*)(vbuf + off); }
#pragma unroll
            for (int i = 0; i < 3; ++i) if (i * 64 < nkeys) { const int key = i * 64 + key0;
                *(LAS u32x4*)(Ks + key * KS_STRIDE + ch * 16) = kv[i];
#pragma unroll
                for (int e = 0; e < 8; ++e) *(LAS unsigned short*)(VT + (ch * 8 + e) * VT_STRIDE + vt_pos(key) * 2) = (unsigned short)((vv[i][e >> 1] >> (16 * (e & 1))) & 0xffffu); }
        } else {
            const int su = unit - 512; const int b = su >> 1; nkeys = 160;
            for (int it = tid; it < nkeys * 8; it += 512) {
                const int key = it >> 3, ch = it & 7; u32x4 kv, vv;
                if (key < 128) {
                    const size_t off = (size_t)((b * 128 + key) * 2 + kvh) * 64 + ch * 8;
                    const f32x4 k0 = *(const f32x4*)(a.in[3] + off), k1 = *(const f32x4*)(a.in[3] + off + 4), v0 = *(const f32x4*)(a.in[4] + off), v1 = *(const f32x4*)(a.in[4] + off + 4);
                    kv = (u32x4){cvt_pk_bf16(k0[0], k0[1]), cvt_pk_bf16(k0[2], k0[3]), cvt_pk_bf16(k1[0], k1[1]), cvt_pk_bf16(k1[2], k1[3])};
                    vv = (u32x4){cvt_pk_bf16(v0[0], v0[1]), cvt_pk_bf16(v0[2], v0[3]), cvt_pk_bf16(v1[0], v1[1]), cvt_pk_bf16(v1[2], v1[3])};
                } else {
                    const size_t off = (size_t)(MP + b * 32 + key - 128) * 128 + kvh * 64 + ch * 8;
                    kv = *(const u32x4*)(kbuf + off); vv = *(const u32x4*)(vbuf + off);
                }
                *(LAS u32x4*)(Ks + key * KS_STRIDE + ch * 16) = kv;
#pragma unroll
                for (int i = 0; i < 8; ++i) *(LAS unsigned short*)(VT + (ch * 8 + i) * VT_STRIDE + vt_pos(key) * 2) = (unsigned short)((vv[i >> 1] >> (16 * (i & 1))) & 0xffffu);
            }
        }
        __syncthreads();
        const float sink2 = sinks[head] * LOG2E; const int nkb = nkeys >> 5;
        bf16x8 qf0[4];
        const bf16_t* qp = q + (size_t)(qrow0 + (lane & 31)) * 1024 + head * 64 + 8 * (lane >> 5);
#pragma unroll
        for (int s = 0; s < 4; ++s) qf0[s] = *(const bf16x8*)(qp + 16 * s);
        attn_qblock(qf0, qrow0, head, nkb, Ks, VT, sink2, yb, lane);
        if (unit < 512) {
#pragma unroll
            for (int s = 0; s < 4; ++s) qf0[s] = *(const bf16x8*)(q + (size_t)(qrow0 + 32 + (lane & 31)) * 1024 + head * 64 + 8 * (lane >> 5) + 16 * s);
            attn_qblock(qf0, qrow0 + 32, head, nkb, Ks, VT, sink2, yb, lane);
        }
    }
    {
        const float* u = (const float*)(ws + WS_U); bf16_t* pooled = (bf16_t*)(ws + WS_POOLED); const float* hist = a.in[2];
        const int gwv = blockIdx.x * 8 + wave, NW = gridDim.x * 8;
        for (int it = gwv; it < (MT / 32) * 4; it += NW) {
            const int g = it & 3, r0 = ((it >> 2) * 2 + (lane >> 5)) * 16, c = g * 128 + (lane & 31) * 4;
            if (g == 0) pool_chunk<2>(u, hist, pooled, r0, c); else if (g == 1) pool_chunk<4>(u, hist, pooled, r0, c); else if (g == 2) pool_chunk<8>(u, hist, pooled, r0, c); else pool_chunk<16>(u, hist, pooled, r0, c);
        }
    }
}

#define XB_TMO      128
#define XB_XCNT(j)  (256  + 64 * (j))
#define XB_XSUB(j)  (1280 + 64 * (j))
#define XB_XGEN(j)  (2304 + 64 * (j))
#define XB_TOP      3328
#define XB_TOPGEN   3392
#define XCD_BAR_WORDS 3456
#define XB_SPIN_CAP (1u << 18)

__device__ __forceinline__ unsigned xb_ld(unsigned* p)              { return __hip_atomic_load(p, __ATOMIC_RELAXED, __HIP_MEMORY_SCOPE_AGENT); }
__device__ __forceinline__ unsigned xb_add(unsigned* p, unsigned v) { return __hip_atomic_fetch_add(p, v, __ATOMIC_RELAXED, __HIP_MEMORY_SCOPE_AGENT); }
__device__ __forceinline__ unsigned xb_xcc_id() { return (unsigned)__builtin_amdgcn_s_getreg((3 << 11) | 20) & 0xFu; }
#define XB_SPIN(cond, bar) do { unsigned _sp = 0; while (cond) {   \
    if ((++_sp & 255u) == 0u) { if (xb_ld(&(bar)[XB_TMO])) break; if (_sp > XB_SPIN_CAP) { atomicAdd(&(bar)[XB_TMO], 1u); break; } } } } while (0)

struct XcdBarrier {
    unsigned* bar; unsigned x;
    volatile LAS unsigned* st;
};

__device__ __forceinline__ XcdBarrier xcd_barrier_post(unsigned* bar, volatile LAS unsigned* st) {
    XcdBarrier b; b.bar = bar; b.x = xb_xcc_id(); b.st = st;
    if (threadIdx.x == 0) (void)xb_add(&bar[XB_XCNT(b.x)], 1u);
    return b;
}
__device__ __forceinline__ void xcd_barrier_complete(unsigned* bar, unsigned x, unsigned& nloc, unsigned& nx) {
    const unsigned G = gridDim.x * gridDim.y * gridDim.z;
    unsigned sum, cnt, mine, sp = 0u;
    for (;;) {
        sum = 0u; cnt = 0u; mine = 0u;
#pragma unroll
        for (unsigned j = 0; j < 16; ++j) { const unsigned c = xb_ld(&bar[XB_XCNT(j)]); sum += c; cnt += (c > 0u) ? 1u : 0u; mine = (j == x) ? c : mine; }
        if (sum == G) break;
        __builtin_amdgcn_s_sleep(1);
        if ((++sp & 255u) == 0u) { if (xb_ld(&bar[XB_TMO])) break; if (sp > XB_SPIN_CAP) { atomicAdd(&bar[XB_TMO], 1u); break; } }
    }
    nloc = mine > 0u ? mine : 1u; nx = cnt > 0u ? cnt : 1u;
}

__device__ __forceinline__ void xcd_barrier(const XcdBarrier& b) {
    asm volatile("s_waitcnt vmcnt(0)" ::: "memory");
    __syncthreads();
    if (threadIdx.x == 0) {
        unsigned* bar = b.bar;
        __builtin_amdgcn_s_waitcnt(0);
        unsigned nloc = b.st[0], nx = b.st[1];
        if (nloc == 0u) { xcd_barrier_complete(bar, b.x, nloc, nx); b.st[0] = nloc; b.st[1] = nx; }
        const unsigned old = xb_add(&bar[XB_XSUB(b.x)], 1u);
        const unsigned gen = old / nloc;
        if (old + 1u == (gen + 1u) * nloc) {
            __builtin_amdgcn_fence(__ATOMIC_RELEASE, "agent");
            asm volatile("s_waitcnt vmcnt(0)" ::: "memory");
            const unsigned og = xb_add(&bar[XB_TOP], 1u);
            const unsigned tg = og / nx;
            if (og + 1u == (tg + 1u) * nx) xb_add(&bar[XB_TOPGEN], 1u);
            else XB_SPIN(xb_ld(&bar[XB_TOPGEN]) == tg, bar);
            __builtin_amdgcn_fence(__ATOMIC_ACQUIRE, "agent");
            xb_add(&bar[XB_XGEN(b.x)], 1u);
            asm volatile("s_waitcnt vmcnt(0)" ::: "memory");
        } else {
            XB_SPIN(xb_ld(&bar[XB_XGEN(b.x)]) == gen, bar);
            __builtin_amdgcn_fence(__ATOMIC_ACQUIRE, "agent");
            asm volatile("s_waitcnt vmcnt(0)" ::: "memory");
        }
    }
    __syncthreads();
}

constexpr int LDS_BYTES = 143360;
#define GEMM_PHASE_M(EPI, M_, A_, B_, N_, K_, E_) do { pg8::Gemm g_{(const bf16_t*)(A_), (const bf16_t*)(B_), (M_), (N_), (K_), (K_), 0}; pg8::StaticOrder S_; S_.init((M_), (N_), (int)gridDim.x, (int)blockIdx.x); \
        pg8::gemm_phase<EPI, pg8::StaticOrder, true, true>(lds, g_, S_, (E_)); } while (0)
#define GEMM_PHASE(EPI, A_, B_, N_, K_, E_) GEMM_PHASE_M(EPI, MT, A_, B_, N_, K_, E_)
#define GEMM_PHASE_IDX(EPI, A_, B_, N_, K_, E_) do { pg8::Gemm g_{(const bf16_t*)(A_), (const bf16_t*)(B_), MT, (N_), (K_), (K_), 0}; IndexedOrder S_; S_.init(MT, (N_), (int)gridDim.x, (int)blockIdx.x); \
        pg8::gemm_phase<EPI, IndexedOrder, true, true>(lds, g_, S_, (E_)); } while (0)
#define COMBO_PHASE(EPI, A_, B_, K_, S_, SOFF_, E_) do { pg8::Gemm g_{(const bf16_t*)(A_), (const bf16_t*)(B_), MT, D, (K_), (K_), 512}; ComboOrder<S_> S_o; \
        S_o.init(MP, D, (int)gridDim.x, (int)blockIdx.x); S_o.soff = (SOFF_); pg8::gemm_phase<EPI, ComboOrder<S_>, true, true>(lds, g_, S_o, (E_)); } while (0)

struct IndexedOrder : pg8::StaticOrder {
    __device__ bool next(int i, Unit& u) const { const bool ok = pg8::StaticOrder::next(i, u); u.ks = i; return ok; }
};
constexpr int LDS_RS = 131072 + 64, RS_MAX_UNITS = 7;
__device__ __forceinline__ void rs_table(LAS unsigned char* lds, const float* ss, int N, int tid, const float* bgate) {
    IndexedOrder S; S.init(MT, N, (int)gridDim.x, (int)blockIdx.x); Unit u; LAS float* lrs = (LAS float*)(lds + LDS_RS);
    for (int i = 0; i < RS_MAX_UNITS && S.next(i, u); ++i) if (tid < 256) { lrs[i * 256 + tid] = rstd_of(ss, u.pm * 256 + tid);
        if (bgate && i < 4 && u.pn >= 7) lrs[LDS_T2_OFF + i * 256 + tid] = bgate[(u.pn - 7) * 256 + tid]; }
    __syncthreads();
}
#define IDLE_CONVERT(PART_, FIRST_) do { const int f_ = (FIRST_), G_ = (int)gridDim.x; \
        if (f_ > 0 && f_ < G_) { if ((int)blockIdx.x >= f_) prologue<PART_>(a, lds, tid, lane, wave, ((int)blockIdx.x - f_) * 8 + wave, (G_ - f_) * 8); } \
        else prologue<PART_>(a, lds, tid, lane, wave, (int)blockIdx.x * 8 + wave, G_ * 8); } while (0)

__global__ void __launch_bounds__(512, 2) mk_fwd(Args a) {
    extern __shared__ __attribute__((aligned(16))) unsigned char lds_raw[];
    LAS unsigned char* lds = (LAS unsigned char*)lds_raw;
    cg::grid_group grid = cg::this_grid();
    const int tid = threadIdx.x, lane = tid & 63, wave = __builtin_amdgcn_readfirstlane(tid >> 6);
    unsigned char* ws = a.ws;
    float* ss = (float*)(ws + WS_SS);
    bf16_t* xb = (bf16_t*)(ws + WS_XB); bf16_t* act = (bf16_t*)(ws + WS_ACT);
    float* y = a.out;

    if (tid < 16) ((LAS unsigned*)(lds + 131072))[tid] = 0u;
    if (blockIdx.x == 0 && tid < 17) { unsigned* bw = (unsigned*)(ws + WS_BAR);
        if (tid < 16) { __hip_atomic_store(bw + XB_XCNT(tid), 0u, __ATOMIC_RELAXED, __HIP_MEMORY_SCOPE_AGENT); __hip_atomic_store(bw + XB_XSUB(tid), 0u, __ATOMIC_RELAXED, __HIP_MEMORY_SCOPE_AGENT); __hip_atomic_store(bw + XB_XGEN(tid), 0u, __ATOMIC_RELAXED, __HIP_MEMORY_SCOPE_AGENT); }
        else { __hip_atomic_store(bw + XB_TMO, 0u, __ATOMIC_RELAXED, __HIP_MEMORY_SCOPE_AGENT); __hip_atomic_store(bw + XB_TOP, 0u, __ATOMIC_RELAXED, __HIP_MEMORY_SCOPE_AGENT); __hip_atomic_store(bw + XB_TOPGEN, 0u, __ATOMIC_RELAXED, __HIP_MEMORY_SCOPE_AGENT); } }
    __syncthreads();
    XcdBarrier bar; bar.bar = (unsigned*)(ws + WS_BAR); bar.x = xb_xcc_id(); bar.st = (volatile LAS unsigned*)(lds + 131072);
    grid.sync();
    if (tid == 0) (void)xb_add(&bar.bar[XB_XCNT(bar.x)], 1u);
    prologue<0>(a, lds, tid, lane, wave, blockIdx.x * 8 + wave, gridDim.x * 8);
    xcd_barrier(bar);
    { EpiSwiglu<false> E{act, nullptr}; GEMM_PHASE(EpiSwiglu<false>, xb, ws + WS_W1, 2 * FF, D, E); }
    IDLE_CONVERT(2, ((MT / 256) * (2 * FF / 256)) % (int)gridDim.x);
    xcd_barrier(bar);
    { EpiResid<0> E{a.in[0], a.in[1], y, xb, ss, 0.5f, (float*)(ws + WS_R)}; COMBO_PHASE(EpiResid<0>, act, ws + WS_W2, FF, 11, 0, E); }
    xcd_barrier(bar);
    reduce_resid<11, 0>((const float*)(ws + WS_R), a.in[1], y, xb, ss, 0.5f, lane, wave);
    prologue<1>(a, lds, tid, lane, wave, blockIdx.x * 8 + wave, gridDim.x * 8);
    xcd_barrier(bar);
    rs_table(lds, ss, DIN, tid, a.in[10]);
    { EpiWin E{(const LAS float*)(lds + LDS_RS), (float*)(ws + WS_U), (bf16_t*)(ws + WS_Q), (bf16_t*)(ws + WS_KB), (bf16_t*)(ws + WS_VB), (bf16_t*)(ws + WS_GATES), a.in[10], a.in[14], a.in[15], a.out};
      GEMM_PHASE_IDX(EpiWin, xb, ws + WS_WIN, DIN, D, E); }
    IDLE_CONVERT(3, ((MT / 256) * (DIN / 256)) % (int)gridDim.x);
    xcd_barrier(bar);
    attn_pool_phase(a, lds, tid, lane, wave);
    xcd_barrier(bar);
    { EpiMix1 E{(const bf16_t*)(ws + WS_GATES), (const float*)(ws + WS_BC), (bf16_t*)(ws + WS_T), (float*)(ws + WS_SLAB5A)}; COMBO_PHASE(EpiMix1, ws + WS_POOLED, ws + WS_WC, DPOOL, 2, 0, E); }
    { EpiMix2 E{(const bf16_t*)(ws + WS_GATES), (const bf16_t*)(ws + WS_T), (bf16_t*)(ws + WS_MIX), (float*)(ws + WS_SLAB5B)}; COMBO_PHASE(EpiMix2, a.out, ws + WS_WAP, D, 4, 16, E); }
    IDLE_CONVERT(4, 48);
    xcd_barrier(bar);
    reduce_mix<2, 4>((const float*)(ws + WS_SLAB5A), (const float*)(ws + WS_SLAB5B), (const bf16_t*)(ws + WS_GATES), (const float*)(ws + WS_BC), (bf16_t*)(ws + WS_MIX), lane, wave);
    xcd_barrier(bar);
    { EpiResid<1> E{nullptr, nullptr, y, xb, ss, 1.0f, (float*)(ws + WS_T)}; COMBO_PHASE(EpiResid<1>, ws + WS_MIX, ws + WS_WO, D, 4, 0, E); }
    xcd_barrier(bar);
    reduce_resid<4, 1>((const float*)(ws + WS_T), nullptr, y, xb, ss, 1.0f, lane, wave);
    xcd_barrier(bar);
    rs_table(lds, ss, 2 * FF, tid, nullptr);
    { EpiSwiglu<true> E{act, (const LAS float*)(lds + LDS_RS)}; GEMM_PHASE_IDX(EpiSwiglu<true>, xb, ws + WS_W3, 2 * FF, D, E); }
    IDLE_CONVERT(5, ((MT / 256) * (2 * FF / 256)) % (int)gridDim.x);
    xcd_barrier(bar);
    { EpiResid<2> E{nullptr, nullptr, y, xb, nullptr, 0.5f, (float*)(ws + WS_R)}; COMBO_PHASE(EpiResid<2>, act, ws + WS_W4, FF, 11, 0, E); }
    xcd_barrier(bar);
    reduce_resid<11, 2>((const float*)(ws + WS_R), nullptr, y, xb, nullptr, 0.5f, lane, wave);
}
}

extern "C" void kernel_launch(void* const* d_in, const int* in_sizes, int n_in, void* d_out, int out_size, void* d_ws, size_t ws_size, hipStream_t stream) {
    static int grid = 0;
    if (grid == 0) {
        if (n_in != 23 || out_size != (int)mk::OUT_TOTAL || ws_size < mk::WS_END) { fprintf(stderr, "kernel_launch: unexpected shapes (n_in %d out %d ws %zu)\n", n_in, out_size, ws_size); grid = -1; return; }
        int dev = 0, cus = 0, per_cu = 0;
        hipGetDevice(&dev); hipDeviceGetAttribute(&cus, hipDeviceAttributeMultiprocessorCount, dev);
        hipFuncSetAttribute((const void*)mk::mk_fwd, hipFuncAttributeMaxDynamicSharedMemorySize, mk::LDS_BYTES);
        hipOccupancyMaxActiveBlocksPerMultiprocessor(&per_cu, (const void*)mk::mk_fwd, 512, mk::LDS_BYTES);
        if (per_cu < 1) per_cu = 1;
        grid = cus * per_cu;
        if (grid * 7 < 66 * 22 || grid * 4 < 66 * 15) { fprintf(stderr, "kernel_launch: %d workgroups; the per-phase row-factor table holds 7 tiles per workgroup (needs >= 208 workgroups)\n", grid); grid = -1; return; }
    }
    if (grid < 0) return;
    mk::Args a{};
    for (int i = 0; i < 23; ++i) a.in[i] = (const float*)d_in[i];
    a.out = (float*)d_out; a.ws = (unsigned char*)d_ws;
    void* args[] = {&a};
    hipError_t e = hipLaunchCooperativeKernel((const void*)mk::mk_fwd, dim3(grid), dim3(512), args, mk::LDS_BYTES, stream);
    if (e != hipSuccess) fprintf(stderr, "cooperative launch failed: %s (grid %d)\n", hipGetErrorString(e), grid);
}
```

```cpp
#include <hip/hip_runtime.h>
#include <hip/hip_cooperative_groups.h>
#include <cstdio>
#include <cstdint>
namespace cg = cooperative_groups;
namespace pg8 {
#define PG8_LAS __attribute__((address_space(3)))
typedef unsigned short bf16_t;
typedef short bf16x8 __attribute__((ext_vector_type(8)));
typedef float f32x4 __attribute__((ext_vector_type(4)));
typedef unsigned u32x4 __attribute__((ext_vector_type(4)));
constexpr int BM = 256, BK = 64, HALF = 128, HTB = HALF * BK * 2  , STAGE_BYTES = 8 * HTB, NXCD = 8, WGM = 8;

__host__ __device__ __forceinline__ int lds_byte(int r, int c) { const int st = (r >> 4) * 2 + (c >> 5), rr = r & 15, cc = c & 31, ob = rr * 64 + cc * 2; return st * 1024 + (ob ^ (((ob >> 9) & 1) << 5)); }
__host__ __device__ __forceinline__ void stage_rc(int b, int& R, int& C) { const int st = b / 1024, sb = b % 1024, swz = sb ^ (((sb >> 9) & 1) << 5); R = (st >> 1) * 16 + swz / 64; C = (st & 1) * 32 + (swz % 64) / 2; }
__host__ __device__ __forceinline__ int perm32(int rho) { const int n = rho >> 4, i = rho & 15; return 8 * (i >> 2) + 4 * n + (i & 3); }

struct Unit { int pm, pn, ks, nt; };
struct Gemm { const bf16_t* A; const bf16_t* Bt; int M, N, K, ld, ksb; };

struct StaticOrder {
    int nM, nN, nwg, G, c;
    __host__ __device__ void init(int M, int N, int G_, int c_) { nM = M / BM; nN = N / BM; nwg = nM * nN; G = G_; c = c_; }
    __host__ __device__ bool next(int i, Unit& u) const {
        const long L = (long)i * G + c; if (L >= nwg) return false;
        int wgid = (int)L; { const int q = nwg / NXCD, r = nwg % NXCD, xcd = wgid % NXCD, off = wgid / NXCD; wgid = (xcd < r ? xcd * (q + 1) : r * (q + 1) + (xcd - r) * q) + off; }
        const int nig = WGM * nN, gid = wgid / nig, fm = gid * WGM, gsz = (nM - fm) < WGM ? (nM - fm) : WGM;
        u.pm = fm + ((wgid % nig) % gsz); u.pn = (wgid % nig) / gsz; u.ks = 0; u.nt = 0; return true;
    }
    __device__ __forceinline__ void a_ready(const Unit&) const {}
    __device__ __forceinline__ void done(const Unit&) const {}
};

typedef __bf16 bf16x2_t __attribute__((ext_vector_type(2)));
typedef float f32x2_t __attribute__((ext_vector_type(2)));
__device__ __forceinline__ unsigned cvt_pk_bf16(float lo, float hi) { const f32x2_t v = {lo, hi}; const bf16x2_t b = __builtin_convertvector(v, bf16x2_t); return __builtin_bit_cast(unsigned, b); }
typedef float f32x2 __attribute__((ext_vector_type(2)));
template <class Epi, class Sched, bool ALIGN_EPI = false, bool SP2 = false>
__device__ __forceinline__ void gemm_phase(PG8_LAS unsigned char* lds, const Gemm g, const Sched& S, const Epi& E) {
    const int tid = threadIdx.x, wid = __builtin_amdgcn_readfirstlane(tid >> 6), lane = tid & 63, wr = wid >> 2, wc = wid & 3, fr = lane & 15, fq = lane >> 4;
    const int K = g.ld, nt = g.K / BK;
    const size_t sstep = (size_t)g.ksb;
    unsigned voffA[2], voffB[2];
#pragma unroll
    for (int i = 0; i < 2; ++i) { int R, C; stage_rc(tid * 16 + i * 8192, R, C); const int Rb = Epi::PERM ? ((R & ~31) + perm32(R & 31)) : R;
        voffA[i] = (unsigned)(R * K + C) * 2u; voffB[i] = (unsigned)(Rb * K + C) * 2u; }
    const size_t kstep = (size_t)(BK * 2);
    const size_t hstep = (size_t)HALF * K * 2;
    const size_t tstep = 2 * hstep;
    const unsigned ldsw = (unsigned)wid * 1024u;
    const int aoff = lds_byte(wr * 64 + fr, fq * 8), boff = lds_byte(wc * 32 + fr, fq * 8);
#define PG8_SA(b, h) (((b) * 2 + (h)) * HTB)
#define PG8_SB(b, h) ((4 + (b) * 2 + (h)) * HTB)
#define PG8_STAGE(bufoff, gbase, voff) do { _Pragma("unroll") for (int _i = 0; _i < 2; ++_i) \
        __builtin_amdgcn_global_load_lds((const unsigned*)((const char*)(gbase) + (voff)[_i]), (PG8_LAS unsigned*)(lds + (bufoff) + ldsw + _i * 8192), 16, 0, 0); } while (0)
#define PG8_LDA(dst, b, h) do { _Pragma("unroll") for (int m = 0; m < 4; ++m) _Pragma("unroll") for (int k = 0; k < 2; ++k) dst[m][k] = *(const PG8_LAS bf16x8*)(lds + PG8_SA(b, h) + aoff + m * 2048 + k * 1024); } while (0)
#define PG8_LDB(dst, b, h) do { _Pragma("unroll") for (int n = 0; n < 2; ++n) _Pragma("unroll") for (int k = 0; k < 2; ++k) dst[n][k] = *(const PG8_LAS bf16x8*)(lds + PG8_SB(b, h) + boff + n * 2048 + k * 1024); } while (0)
#define PG8_MMA(ai, bj, At, Bt) do { __builtin_amdgcn_s_setprio(1); _Pragma("unroll") for (int m = 0; m < 4; ++m) _Pragma("unroll") for (int n = 0; n < 2; ++n) _Pragma("unroll") for (int k = 0; k < 2; ++k) \
        acc[ai][bj][m][n] = __builtin_amdgcn_mfma_f32_16x16x32_bf16(Bt[n][k], At[m][k], acc[ai][bj][m][n], 0, 0, 0); __builtin_amdgcn_s_setprio(0); } while (0)
#define PG8_WAIT_V(n) asm volatile("s_waitcnt vmcnt(" #n ")" ::: "memory")
#define PG8_WAIT_L(n) asm volatile("s_waitcnt lgkmcnt(" #n ")" ::: "memory")
#define PG8_BAR __builtin_amdgcn_s_barrier()
#define PG8_SCHED __builtin_amdgcn_sched_barrier(0)
    Unit cur, nxt; int ui = 0;
    if (!S.next(0, cur)) return;
    f32x4 acc[2][2][4][2];
#pragma unroll
    for (int a = 0; a < 2; ++a)
#pragma unroll
        for (int b = 0; b < 2; ++b)
#pragma unroll
            for (int m = 0; m < 4; ++m)
#pragma unroll
                for (int n = 0; n < 2; ++n) acc[a][b][m][n] = (f32x4){0.f, 0.f, 0.f, 0.f};
    bf16x8 At[4][2], B0[2][2], B1[2][2];
    const char* cA = (const char*)g.A + (size_t)cur.pm * tstep + (size_t)cur.ks * sstep; const char* cB = (const char*)g.Bt + (size_t)cur.pn * tstep + (size_t)cur.ks * sstep;
    S.a_ready(cur);
    if constexpr (SP2) {
        PG8_STAGE(PG8_SB(0, 0), cB, voffB); PG8_STAGE(PG8_SB(0, 1), cB + hstep, voffB); PG8_STAGE(PG8_SA(0, 0), cA, voffA); PG8_STAGE(PG8_SA(0, 1), cA + hstep, voffA);
        if (wr == 1) PG8_BAR;
        PG8_WAIT_V(2); PG8_BAR;
        PG8_STAGE(PG8_SB(1, 0), cB + kstep, voffB); PG8_STAGE(PG8_SA(1, 0), cA + kstep, voffA); PG8_STAGE(PG8_SB(1, 1), cB + hstep + kstep, voffB);
        PG8_WAIT_V(6); PG8_BAR;
    } else {
        PG8_STAGE(PG8_SB(0, 0), cB, voffB); PG8_STAGE(PG8_SA(0, 0), cA, voffA); PG8_STAGE(PG8_SB(0, 1), cB + hstep, voffB); PG8_STAGE(PG8_SA(0, 1), cA + hstep, voffA);
        if (wr == 1) PG8_BAR;
        PG8_WAIT_V(4); PG8_BAR;
        PG8_STAGE(PG8_SB(1, 0), cB + kstep, voffB); PG8_STAGE(PG8_SA(1, 0), cA + kstep, voffA); PG8_STAGE(PG8_SB(1, 1), cB + hstep + kstep, voffB);
        PG8_WAIT_V(6); PG8_BAR;
    }
    for (;;) {
        const bool has_next = S.next(ui + 1, nxt);
        const char* nA = has_next ? (const char*)g.A + (size_t)nxt.pm * tstep + (size_t)nxt.ks * sstep : cA; const char* nB = has_next ? (const char*)g.Bt + (size_t)nxt.pn * tstep + (size_t)nxt.ks * sstep : cB;
        const int ntc = cur.nt ? cur.nt : nt;
        for (int t = 0; t < ntc; t += 2) {
            const bool last = (t == ntc - 2);
            const char* a1 = cA + (size_t)(t + 1) * kstep;
            const char* a2 = last ? nA : cA + (size_t)(t + 2) * kstep; const char* b2 = last ? nB : cB + (size_t)(t + 2) * kstep;
            const char* a3 = a2 + kstep; const char* b3 = b2 + kstep;
            if (last && has_next) S.a_ready(nxt);
            if constexpr (SP2) {
            PG8_LDB(B0, 0, 0); PG8_LDB(B1, 0, 1); PG8_SCHED; PG8_LDA(At, 0, 0); PG8_STAGE(PG8_SA(1, 1), a1 + hstep, voffA);
            PG8_WAIT_V(8); PG8_WAIT_L(0); PG8_BAR; PG8_MMA(0, 0, At, B0); PG8_MMA(0, 1, At, B1); PG8_BAR; PG8_SCHED;
            PG8_LDA(At, 0, 1); PG8_STAGE(PG8_SB(0, 0), b2, voffB); PG8_STAGE(PG8_SB(0, 1), b2 + hstep, voffB); PG8_STAGE(PG8_SA(0, 0), a2, voffA);
            PG8_WAIT_V(8); PG8_WAIT_L(0); PG8_BAR; PG8_MMA(1, 0, At, B0); PG8_MMA(1, 1, At, B1); PG8_BAR; PG8_SCHED;
            PG8_LDB(B0, 1, 0); PG8_LDB(B1, 1, 1); PG8_SCHED; PG8_LDA(At, 1, 0); PG8_STAGE(PG8_SA(0, 1), a2 + hstep, voffA);
            PG8_WAIT_V(8); PG8_WAIT_L(0); PG8_BAR; PG8_MMA(0, 0, At, B0); PG8_MMA(0, 1, At, B1); PG8_BAR; PG8_SCHED;
            PG8_LDA(At, 1, 1); PG8_STAGE(PG8_SB(1, 0), b3, voffB); PG8_STAGE(PG8_SB(1, 1), b3 + hstep, voffB); PG8_STAGE(PG8_SA(1, 0), a3, voffA);
            PG8_WAIT_V(8); PG8_WAIT_L(0); PG8_BAR; PG8_MMA(1, 0, At, B0); PG8_MMA(1, 1, At, B1); PG8_BAR; PG8_SCHED;
            } else {
            PG8_LDB(B0, 0, 0); PG8_SCHED; PG8_LDA(At, 0, 0); PG8_STAGE(PG8_SA(1, 1), a1 + hstep, voffA);
            PG8_WAIT_L(8); PG8_BAR; PG8_WAIT_L(0); PG8_MMA(0, 0, At, B0); PG8_BAR; PG8_SCHED;
            PG8_LDB(B1, 0, 1); PG8_STAGE(PG8_SB(0, 0), b2, voffB);
            PG8_BAR; PG8_WAIT_L(0); PG8_MMA(0, 1, At, B1); PG8_BAR;
            PG8_LDA(At, 0, 1); PG8_STAGE(PG8_SA(0, 0), a2, voffA);
            PG8_BAR; PG8_WAIT_L(0); PG8_MMA(1, 0, At, B0); PG8_BAR; PG8_SCHED;
            PG8_STAGE(PG8_SB(0, 1), b2 + hstep, voffB);
            PG8_WAIT_V(6); PG8_BAR; PG8_MMA(1, 1, At, B1); PG8_BAR;
            PG8_LDB(B0, 1, 0); PG8_SCHED; PG8_LDA(At, 1, 0); PG8_STAGE(PG8_SA(0, 1), a2 + hstep, voffA);
            PG8_WAIT_L(8); PG8_BAR; PG8_WAIT_L(0); PG8_MMA(0, 0, At, B0); PG8_BAR; PG8_SCHED;
            PG8_LDB(B1, 1, 1); PG8_STAGE(PG8_SB(1, 0), b3, voffB);
            PG8_BAR; PG8_WAIT_L(0); PG8_MMA(0, 1, At, B1); PG8_BAR;
            PG8_LDA(At, 1, 1); PG8_STAGE(PG8_SA(1, 0), a3, voffA);
            PG8_BAR; PG8_WAIT_L(0); PG8_MMA(1, 0, At, B0); PG8_BAR; PG8_SCHED;
            PG8_STAGE(PG8_SB(1, 1), b3 + hstep, voffB);
            PG8_WAIT_V(6); PG8_BAR; PG8_MMA(1, 1, At, B1); PG8_BAR;
            }
        }
        if constexpr (ALIGN_EPI) { if (wr == 0) PG8_BAR; }
        if constexpr (!Epi::AFTER_DRAIN) { E(acc, cur, wr, wc, fr, fq); S.done(cur); }
        if (!has_next) break;
#pragma unroll
        for (int a = 0; a < 2; ++a)
#pragma unroll
            for (int b = 0; b < 2; ++b)
#pragma unroll
                for (int m = 0; m < 4; ++m)
#pragma unroll
                    for (int n = 0; n < 2; ++n) acc[a][b][m][n] = (f32x4){0.f, 0.f, 0.f, 0.f};
        cur = nxt; cA = nA; cB = nB; ++ui;
        if constexpr (ALIGN_EPI) { if (wr == 1) PG8_BAR; }
    }
    PG8_WAIT_V(0);
    if constexpr (!ALIGN_EPI) { if (wr == 0) PG8_BAR; }
    PG8_BAR;
    if constexpr (Epi::AFTER_DRAIN) { E.fused(acc, cur, wr, wc, fr, fq, lds, wid, lane); S.done(cur); }
#undef PG8_SA
#undef PG8_SB
#undef PG8_STAGE
#undef PG8_LDA
#undef PG8_LDB
#undef PG8_MMA
#undef PG8_WAIT_V
#undef PG8_WAIT_L
#undef PG8_BAR
#undef PG8_SCHED
}
}

namespace mk {
#define LAS __attribute__((address_space(3)))
using pg8::bf16_t; using pg8::f32x4; using pg8::u32x4; using pg8::Unit; using pg8::cvt_pk_bf16; using pg8::bf16x8;
typedef unsigned u32x2 __attribute__((ext_vector_type(2)));
typedef float f32x16 __attribute__((ext_vector_type(16)));
typedef unsigned long long u64;

constexpr int MP = 16384, MS = 512, MT = MP + MS, D = 1024, FF = 2816, DIN = 3840, DPOOL = 512;
constexpr float EPS = 1e-6f, LOG2E = 1.4426950408889634f, QSCALE = 0.125f * 1.4426950408889634f;
constexpr size_t OFF_Y = 0, OFF_POOLP = (size_t)MT * D, OFF_KP = OFF_POOLP + 4 * 15 * 512, OFF_VP = OFF_KP + 4 * 128 * 128,
                 OFF_POOLS = OFF_VP + 4 * 128 * 128, OFF_KS = OFF_POOLS + 16 * 15 * 512, OFF_VS = OFF_KS + 16 * 128 * 128, OUT_TOTAL = OFF_VS + 16 * 128 * 128;
constexpr size_t MiB = 1u << 20;
constexpr size_t WS_BC = 0, WS_BCP = 64 * 1024, WS_BAR = 128 * 1024, WS_BAR_BYTES = 16 * 1024, WS_SS = 1 * MiB;
constexpr size_t WS_W1 = 3 * MiB, WS_W3 = 14 * MiB, WS_W2 = 25 * MiB, WS_W4 = WS_W2 + 11 * MiB / 2, WS_WIN = 36 * MiB, WS_WC = WS_WIN + 15 * MiB / 2,
                 WS_WAP = WS_WC + 1 * MiB, WS_WO = WS_WAP + 2 * MiB;
constexpr size_t WS_XB = 49 * MiB;
constexpr size_t WS_ACT = 82 * MiB;
constexpr size_t WS_GATES = WS_ACT, WS_POOLED = WS_GATES + 66 * MiB, WS_KB = WS_POOLED + 33 * MiB / 2, WS_VB = WS_KB + (size_t)MT * 128 * 2;
constexpr size_t WS_R = 173 * MiB;
constexpr size_t WS_U = WS_R, WS_Q = WS_R + 33 * MiB, WS_T = WS_R, WS_MIX = WS_R + 33 * MiB, WS_SLAB5A = WS_R + 66 * MiB, WS_SLAB5B = WS_SLAB5A + 4 * MiB, WS_END = WS_SLAB5B + 8 * MiB;
static_assert(WS_VB + (size_t)MT * 128 * 2 <= WS_ACT + (size_t)MT * FF * 2 && WS_ACT + (size_t)MT * FF * 2 <= WS_R && WS_WO + 2 * MiB <= WS_XB && WS_END <= 256 * MiB, "ws map");
static_assert(WS_SS + (size_t)MT * 16 * 4 <= WS_W1, "ss");

__device__ __forceinline__ float sigm(float x) { return __builtin_amdgcn_rcpf(1.0f + __builtin_amdgcn_exp2f(-x * LOG2E)); }
__device__ __forceinline__ float bflo(unsigned w) { return __builtin_bit_cast(float, w << 16); }
__device__ __forceinline__ float bfhi(unsigned w) { return __builtin_bit_cast(float, w & 0xffff0000u); }
__device__ __forceinline__ float rstd_of(const float* ss, int r) {
    const f32x4* p = (const f32x4*)(ss + (size_t)r * 16);
    const f32x4 s = (p[0] + p[1]) + (p[2] + p[3]);
    return rsqrtf(((s[0] + s[1]) + (s[2] + s[3])) * (1.0f / 1024.0f) + EPS);
}
__device__ __forceinline__ float wave_sum(float v) {
#pragma unroll
    for (int o = 1; o < 64; o <<= 1) v += __shfl_xor(v, o);
    return v;
}


template <bool PERM> __device__ __forceinline__ void slab_store(float* slab_, const f32x4 (&acc)[2][2][4][2], const Unit& u, int wr, int wc, int fr, int fq) {
    bf16_t* base = (bf16_t*)slab_ + ((size_t)u.ks * MS + (u.pm * 256 - MP + wr * 64 + fr)) * D + u.pn * 256 + wc * 32 + (PERM ? fq * 8 : fq * 4);
#pragma unroll
    for (int ai = 0; ai < 2; ++ai)
#pragma unroll
        for (int m = 0; m < 4; ++m)
#pragma unroll
            for (int bj = 0; bj < 2; ++bj)
#pragma unroll
                for (int n = 0; n < 2; ++n) { const f32x4 v = acc[ai][bj][m][n]; u32x2 w; w.x = cvt_pk_bf16(v[0], v[1]); w.y = cvt_pk_bf16(v[2], v[3]);
                    *(u32x2*)(base + (ai * 128 + m * 16) * D + bj * 128 + (PERM ? n * 4 : n * 16)) = w; }
}


template <bool USE_RS> struct EpiSwiglu {
    static constexpr bool PERM = true, AFTER_DRAIN = false;
    bf16_t* O; const LAS float* lrs;
    __device__ __forceinline__ void operator()(const f32x4 (&acc)[2][2][4][2], const Unit& u, int wr, int wc, int fr, int fq) const {
#pragma unroll
        for (int ai = 0; ai < 2; ++ai)
#pragma unroll
            for (int m = 0; m < 4; ++m) {
                const int r = u.pm * 256 + ai * 128 + wr * 64 + m * 16 + fr;
                const float rs = USE_RS ? lrs[u.ks * 256 + ai * 128 + wr * 64 + m * 16 + fr] : 1.0f;
                u32x4 w;
#pragma unroll
                for (int n = 0; n < 2; ++n) {
                    const f32x4 g = acc[ai][0][m][n] * rs, up = acc[ai][1][m][n] * rs;
                    float o[4];
#pragma unroll
                    for (int j = 0; j < 4; ++j) o[j] = g[j] * sigm(g[j]) * up[j];
                    w[2 * n] = cvt_pk_bf16(o[0], o[1]); w[2 * n + 1] = cvt_pk_bf16(o[2], o[3]);
                }
                *(u32x4*)(O + (size_t)r * FF + u.pn * 128 + wc * 32 + fq * 8) = w;
            }
    }
};

template <int MODE> struct EpiResid {
    static constexpr bool PERM = false, AFTER_DRAIN = false;
    const float* resA; const float* resB; float* out; bf16_t* ob; float* ss; float alpha; float* slab;
    __device__ __forceinline__ void operator()(const f32x4 (&acc)[2][2][4][2], const Unit& u, int wr, int wc, int fr, int fq) const {
        if (u.nt) { slab_store<false>(slab, acc, u, wr, wc, fr, fq); return; }
#pragma unroll
        for (int ai = 0; ai < 2; ++ai)
#pragma unroll
            for (int m = 0; m < 4; ++m) {
                const int r = u.pm * 256 + ai * 128 + wr * 64 + m * 16 + fr;
                const float* rp = (r < MP) ? resA + (size_t)r * D : resB + (size_t)(r - MP) * D;
                float sq = 0.f;
#pragma unroll
                for (int bj = 0; bj < 2; ++bj)
#pragma unroll
                    for (int n = 0; n < 2; ++n) {
                        const int c = u.pn * 256 + bj * 128 + wc * 32 + n * 16 + fq * 4;
                        f32x4 v;
                        if (MODE == 0) v = *(const f32x4*)(rp + c);
                        else { const u32x2 b = *(const u32x2*)(ob + (size_t)r * D + c); v = (f32x4){bflo(b.x), bfhi(b.x), bflo(b.y), bfhi(b.y)}; }
                        const f32x4 o = v + acc[ai][bj][m][n] * alpha;
                        if (MODE == 2) *(f32x4*)(out + (size_t)r * D + c) = o;
                        else { u32x2 w; w.x = cvt_pk_bf16(o[0], o[1]); w.y = cvt_pk_bf16(o[2], o[3]); *(u32x2*)(ob + (size_t)r * D + c) = w; }
                        sq += (o[0] * o[0] + o[1] * o[1]) + (o[2] * o[2] + o[3] * o[3]);
                    }
                if (MODE != 2) { sq += __shfl_xor(sq, 16); sq += __shfl_xor(sq, 32); if (fq == 0) ss[(size_t)r * 16 + u.pn * 4 + wc] = sq; }
            }
    }
};

constexpr int LDS_T2_OFF = 7 * 256;
struct EpiWin {
    static constexpr bool PERM = true, AFTER_DRAIN = false;
    const LAS float* lrs; float* uo; bf16_t* q; bf16_t* kb; bf16_t* vb; bf16_t* gates; const float* bgate; const float* qg; const float* kg; float* out;
    __device__ __forceinline__ void operator()(const f32x4 (&acc)[2][2][4][2], const Unit& u, int wr, int wc, int fr, int fq) const {
        const int pn = u.pn;
        if (pn < 2) {
#pragma unroll
            for (int ai = 0; ai < 2; ++ai)
#pragma unroll
                for (int m = 0; m < 4; ++m) {
                    const int r = u.pm * 256 + ai * 128 + wr * 64 + m * 16 + fr;
                    const float rs = lrs[u.ks * 256 + ai * 128 + wr * 64 + m * 16 + fr];
                    float* o2 = nullptr;
                    if (r < MP) { const int s = r & 4095; if (s >= 4081) o2 = out + OFF_POOLP + (size_t)((r >> 12) * 15 + (s - 4081)) * 512; }
                    else { const int rr = r - MP, t = rr & 31; if (t >= 17) o2 = out + OFF_POOLS + (size_t)((rr >> 5) * 15 + (t - 17)) * 512; }
#pragma unroll
                    for (int bj = 0; bj < 2; ++bj)
#pragma unroll
                        for (int n = 0; n < 2; ++n) {
                            const int c = pn * 256 + bj * 128 + wc * 32 + fq * 8 + n * 4;
                            const f32x4 v = acc[ai][bj][m][n] * rs;
                            *(f32x4*)(uo + (size_t)r * 512 + c) = v;
                            if (o2) *(f32x4*)(o2 + c) = v;
                        }
                }
        } else if (pn < 7) {
            const bool is_q = pn < 6, is_v = (!is_q) && wc >= 2;
            const float* gp = is_q ? qg : kg;
            f32x4 gn[2][2];
#pragma unroll
            for (int bj = 0; bj < 2; ++bj)
#pragma unroll
                for (int n = 0; n < 2; ++n) { gn[bj][n] = *(const f32x4*)(gp + bj * 32 + fq * 8 + n * 4); if (is_q) gn[bj][n] = gn[bj][n] * QSCALE; }
#pragma unroll
            for (int ai = 0; ai < 2; ++ai)
#pragma unroll
                for (int m = 0; m < 4; ++m) {
                    const int r = u.pm * 256 + ai * 128 + wr * 64 + m * 16 + fr;
                    const float rs = lrs[u.ks * 256 + ai * 128 + wr * 64 + m * 16 + fr];
                    f32x4 v[2][2]; float sq = 0.f;
#pragma unroll
                    for (int bj = 0; bj < 2; ++bj)
#pragma unroll
                        for (int n = 0; n < 2; ++n) { v[bj][n] = acc[ai][bj][m][n] * rs; const f32x4 t = v[bj][n]; sq += (t[0] * t[0] + t[1] * t[1]) + (t[2] * t[2] + t[3] * t[3]); }
                    sq += __shfl_xor(sq, 16); sq += __shfl_xor(sq, 32);
                    const float r2 = rsqrtf(sq * (1.0f / 64.0f) + EPS);
                    if (!is_v) {
#pragma unroll
                        for (int bj = 0; bj < 2; ++bj)
#pragma unroll
                            for (int n = 0; n < 2; ++n) v[bj][n] = v[bj][n] * r2 * gn[bj][n];
                    }
                    bf16_t* dst; float* o2 = nullptr;
                    if (is_q) dst = q + (size_t)r * 1024 + ((pn - 2) * 4 + wc) * 64;
                    else {
                        const int kvh = wc & 1;
                        dst = (is_v ? vb : kb) + (size_t)r * 128 + kvh * 64;
                        const size_t ob = is_v ? OFF_VP : OFF_KP, obs = is_v ? OFF_VS : OFF_KS;
                        if (r < MP) { const int s = r & 4095; if (s >= 3968) o2 = out + ob + (size_t)(((r >> 12) * 128 + (s - 3968)) * 2 + kvh) * 64; }
                        else { const int rr = r - MP; o2 = out + obs + (size_t)(((rr >> 5) * 128 + 96 + (rr & 31)) * 2 + kvh) * 64; }
                    }
#pragma unroll
                    for (int bj = 0; bj < 2; ++bj) {
                        u32x4 w; w.x = cvt_pk_bf16(v[bj][0][0], v[bj][0][1]); w.y = cvt_pk_bf16(v[bj][0][2], v[bj][0][3]);
                        w.z = cvt_pk_bf16(v[bj][1][0], v[bj][1][1]); w.w = cvt_pk_bf16(v[bj][1][2], v[bj][1][3]);
                        *(u32x4*)(dst + bj * 32 + fq * 8) = w;
                        if (o2) { *(f32x4*)(o2 + bj * 32 + fq * 8) = v[bj][0]; *(f32x4*)(o2 + bj * 32 + fq * 8 + 4) = v[bj][1]; }
                    }
                }
        } else {
            const int gc0 = (pn - 7) * 256 + wc * 32 + fq * 8;
            f32x4 bv[2][2];
#pragma unroll
            for (int bj = 0; bj < 2; ++bj)
#pragma unroll
                for (int n = 0; n < 2; ++n) bv[bj][n] = *(const LAS f32x4*)(lrs + LDS_T2_OFF + u.ks * 256 + wc * 32 + fq * 8 + bj * 128 + n * 4);
#pragma unroll
            for (int ai = 0; ai < 2; ++ai)
#pragma unroll
                for (int m = 0; m < 4; ++m) {
                    const int r = u.pm * 256 + ai * 128 + wr * 64 + m * 16 + fr;
                    const float rs = lrs[u.ks * 256 + ai * 128 + wr * 64 + m * 16 + fr];
#pragma unroll
                    for (int bj = 0; bj < 2; ++bj) {
                        u32x4 w;
#pragma unroll
                        for (int n = 0; n < 2; ++n) {
                            const f32x4 z = acc[ai][bj][m][n] * rs + bv[bj][n];
                            w[2 * n] = cvt_pk_bf16(sigm(z[0]), sigm(z[1])); w[2 * n + 1] = cvt_pk_bf16(sigm(z[2]), sigm(z[3]));
                        }
                        *(u32x4*)(gates + (size_t)r * 2048 + gc0 + bj * 128) = w;
                    }
                }
        }
    }
};


struct EpiMix1 {
    static constexpr bool PERM = true, AFTER_DRAIN = false;
    const bf16_t* gates; const float* bc; bf16_t* t; float* slab;
    __device__ __forceinline__ void operator()(const f32x4 (&acc)[2][2][4][2], const Unit& u, int wr, int wc, int fr, int fq) const {
        if (u.nt) { slab_store<true>(slab, acc, u, wr, wc, fr, fq); return; }
        const int c0 = u.pn * 256 + wc * 32 + fq * 8;
        f32x4 bv[2][2];
#pragma unroll
        for (int bj = 0; bj < 2; ++bj)
#pragma unroll
            for (int n = 0; n < 2; ++n) bv[bj][n] = *(const f32x4*)(bc + c0 + bj * 128 + n * 4);
#pragma unroll
        for (int ai = 0; ai < 2; ++ai)
#pragma unroll
            for (int m = 0; m < 4; ++m) {
                const int r = u.pm * 256 + ai * 128 + wr * 64 + m * 16 + fr;
#pragma unroll
                for (int bj = 0; bj < 2; ++bj) {
                    const int c = c0 + bj * 128;
                    const u32x4 g = *(const u32x4*)(gates + (size_t)r * 2048 + c);
                    const f32x4 a0 = acc[ai][bj][m][0] + bv[bj][0], a1 = acc[ai][bj][m][1] + bv[bj][1];
                    u32x4 w;
                    w.x = cvt_pk_bf16(bflo(g.x) * a0[0], bfhi(g.x) * a0[1]); w.y = cvt_pk_bf16(bflo(g.y) * a0[2], bfhi(g.y) * a0[3]);
                    w.z = cvt_pk_bf16(bflo(g.z) * a1[0], bfhi(g.z) * a1[1]); w.w = cvt_pk_bf16(bflo(g.w) * a1[2], bfhi(g.w) * a1[3]);
                    *(u32x4*)(t + (size_t)r * 1024 + c) = w;
                }
            }
    }
};
struct EpiMix2 {
    static constexpr bool PERM = true, AFTER_DRAIN = false;
    const bf16_t* gates; const bf16_t* t; bf16_t* mix; float* slab;
    __device__ __forceinline__ void operator()(const f32x4 (&acc)[2][2][4][2], const Unit& u, int wr, int wc, int fr, int fq) const {
        if (u.nt) { slab_store<true>(slab, acc, u, wr, wc, fr, fq); return; }
        const int c0 = u.pn * 256 + wc * 32 + fq * 8;
#pragma unroll
        for (int ai = 0; ai < 2; ++ai)
#pragma unroll
            for (int m = 0; m < 4; ++m) {
                const int r = u.pm * 256 + ai * 128 + wr * 64 + m * 16 + fr;
#pragma unroll
                for (int bj = 0; bj < 2; ++bj) {
                    const int c = c0 + bj * 128;
                    const u32x4 g = *(const u32x4*)(gates + (size_t)r * 2048 + 1024 + c);
                    const u32x4 tv = *(const u32x4*)(t + (size_t)r * 1024 + c);
                    const f32x4 a0 = acc[ai][bj][m][0], a1 = acc[ai][bj][m][1];
                    u32x4 w;
                    w.x = cvt_pk_bf16(bflo(tv.x) + bflo(g.x) * a0[0], bfhi(tv.x) + bfhi(g.x) * a0[1]); w.y = cvt_pk_bf16(bflo(tv.y) + bflo(g.y) * a0[2], bfhi(tv.y) + bfhi(g.y) * a0[3]);
                    w.z = cvt_pk_bf16(bflo(tv.z) + bflo(g.z) * a1[0], bfhi(tv.z) + bfhi(g.z) * a1[1]); w.w = cvt_pk_bf16(bflo(tv.w) + bflo(g.w) * a1[2], bfhi(tv.w) + bfhi(g.w) * a1[3]);
                    *(u32x4*)(mix + (size_t)r * 1024 + c) = w;
                }
            }
    }
};


template <int S> struct ComboOrder : pg8::StaticOrder {
    int soff;
    __device__ bool next(int i, Unit& u) const {
        const int L = i * G + c;
        if (L < nwg) return pg8::StaticOrder::next(i, u);
        const int i0 = (c < nwg) ? (nwg - c + G - 1) / G : 0;
        const int j = (c - soff + G) % G + (i - i0) * G;
        if (j >= 8 * S) return false;
        const int t = j / S; u.pm = MP / 256 + (t >> 2); u.pn = t & 3; u.ks = j - t * S; u.nt = 4; return true;
    }
};
template <int S> __device__ __forceinline__ f32x4 slab_sum(const float* slab_, int rl, int c) {
    const bf16_t* slab = (const bf16_t*)slab_;
    u32x2 v[S];
#pragma unroll
    for (int k = 0; k < S; ++k) v[k] = *(const u32x2*)(slab + ((size_t)k * MS + rl) * D + c);
    f32x4 s = (f32x4){bflo(v[0].x), bfhi(v[0].x), bflo(v[0].y), bfhi(v[0].y)};
#pragma unroll
    for (int k = 1; k < S; ++k) s += (f32x4){bflo(v[k].x), bfhi(v[k].x), bflo(v[k].y), bfhi(v[k].y)};
    return s;
}
template <int S, int MODE> __device__ __forceinline__ void reduce_resid(const float* slab, const float* res_base  , float* out  , bf16_t* ob, float* ss, float alpha, int lane, int wave) {
    for (int it = blockIdx.x * 8 + wave; it < MS * 4; it += gridDim.x * 8) {
        const int rl = it >> 2, pn = it & 3, c = pn * 256 + lane * 4;
        f32x4 v;
        if (MODE == 0) v = *(const f32x4*)(res_base + (size_t)rl * D + c);
        else { const u32x2 b = *(const u32x2*)(ob + (size_t)(MP + rl) * D + c); v = (f32x4){bflo(b.x), bfhi(b.x), bflo(b.y), bfhi(b.y)}; }
        const f32x4 o = v + slab_sum<S>(slab, rl, c) * alpha;
        if (MODE == 2) *(f32x4*)(out + (size_t)(MP + rl) * D + c) = o;
        else { u32x2 w; w.x = cvt_pk_bf16(o[0], o[1]); w.y = cvt_pk_bf16(o[2], o[3]); *(u32x2*)(ob + (size_t)(MP + rl) * D + c) = w;
            float sq = (o[0] * o[0] + o[1] * o[1]) + (o[2] * o[2] + o[3] * o[3]);
            sq += __shfl_xor(sq, 1); sq += __shfl_xor(sq, 2); sq += __shfl_xor(sq, 4); sq += __shfl_xor(sq, 32);
            if (lane < 32 && (lane & 7) == 0) ss[(size_t)(MP + rl) * 16 + pn * 4 + (lane >> 3)] = sq; }
    }
}
template <int S1, int S2> __device__ __forceinline__ void reduce_mix(const float* slab1, const float* slab2, const bf16_t* gates, const float* bc, bf16_t* mix, int lane, int wave) {
    for (int it = blockIdx.x * 8 + wave; it < MS * 4; it += gridDim.x * 8) {
        const int rl = it >> 2, pn = it & 3, c = pn * 256 + lane * 4;
        const f32x4 a1 = slab_sum<S1>(slab1, rl, c) + *(const f32x4*)(bc + c), a2 = slab_sum<S2>(slab2, rl, c);
        const u32x2 ga = *(const u32x2*)(gates + (size_t)(MP + rl) * 2048 + c), gb = *(const u32x2*)(gates + (size_t)(MP + rl) * 2048 + 1024 + c);
        u32x2 w; w.x = cvt_pk_bf16(bflo(ga.x) * a1[0] + bflo(gb.x) * a2[0], bfhi(ga.x) * a1[1] + bfhi(gb.x) * a2[1]);
        w.y = cvt_pk_bf16(bflo(ga.y) * a1[2] + bflo(gb.y) * a2[2], bfhi(ga.y) * a1[3] + bfhi(gb.y) * a2[3]);
        *(u32x2*)(mix + (size_t)(MP + rl) * D + c) = w;
    }
}

__device__ __forceinline__ unsigned f2bf(float f) { unsigned u = __builtin_bit_cast(unsigned, f); return (u + 0x7fffu + ((u >> 16) & 1u)) >> 16; }
__device__ __forceinline__ unsigned pk2(float lo, float hi) { return f2bf(lo) | (f2bf(hi) << 16); }

template <int MAP> __device__ __forceinline__ int rowmap(int n) {
    if (MAP == 1) { if (n < FF) return ((n >> 7) << 8) + (n & 127); n -= FF; return ((n >> 7) << 8) + 128 + (n & 127); }
    if (MAP == 2) { if (n >= 512 && n < 1792) { const int t = n & ~255, lc = n & 255, hh = lc >> 6, d = lc & 63; return t + ((d >> 5) << 7) + (hh << 5) + (d & 31); } return n; }
    return n;
}
template <int MAP> __device__ __forceinline__ void transpose_item(const float* W, int K, int N, const float* gain, bf16_t* WT, LAS float* scr, int item, int lane) {
    const int nblk = N / 32, kb = item / nblk, nb = item % nblk, k0 = 64 * kb, n0 = 32 * nb;
#pragma unroll
    for (int i = 0; i < 8; ++i) { const int kk = 8 * i + (lane >> 3);
        f32x4 w = *(const f32x4*)(W + (size_t)(k0 + kk) * N + n0 + (lane & 7) * 4); if (gain) w = w * gain[k0 + kk];
        LAS float* d = scr + kk * 33 + (lane & 7) * 4; d[0] = w[0]; d[1] = w[1]; d[2] = w[2]; d[3] = w[3]; }
    asm volatile("s_waitcnt lgkmcnt(0)" ::: "memory");
    const int c = lane & 7;
#pragma unroll
    for (int j = 0; j < 4; ++j) { const int n = (lane >> 3) + 8 * j; const LAS float* s = scr + (8 * c) * 33 + n;
        u32x4 o; o.x = pk2(s[0 * 33], s[1 * 33]); o.y = pk2(s[2 * 33], s[3 * 33]); o.z = pk2(s[4 * 33], s[5 * 33]); o.w = pk2(s[6 * 33], s[7 * 33]);
        *(u32x4*)(WT + (size_t)rowmap<MAP>(n0 + n) * K + k0 + 8 * c) = o; }
    asm volatile("s_waitcnt lgkmcnt(0)" ::: "memory");
}

struct Args { const float* in[23]; float* out; unsigned char* ws; };

template <int PART> __device__ __forceinline__ void prologue(const Args& a, LAS unsigned char* lds, int tid, int lane, int wave, int gw, int NGW) {
    unsigned char* ws = a.ws;
    LAS float* scr = (LAS float*)(lds + wave * 16384);
    constexpr int I_UP = (D / 64) * (2 * FF / 32), I_DN = (FF / 64) * (D / 32), I_IN = (D / 64) * (DIN / 32), I_SQ = (D / 64) * (D / 32);
    if (PART == 0) {
        for (int it = gw; it < I_UP; it += NGW) transpose_item<1>(a.in[6], D, 2 * FF, a.in[5], (bf16_t*)(ws + WS_W1), scr, it, lane);
    } else if (PART == 2) {
        for (int it = gw; it < I_DN; it += NGW) transpose_item<0>(a.in[7], FF, D, nullptr, (bf16_t*)(ws + WS_W2), scr, it, lane);
    } else if (PART == 1) {
        for (int it = gw; it < I_IN; it += NGW) transpose_item<2>(a.in[9], D, DIN, a.in[8], (bf16_t*)(ws + WS_WIN), scr, it, lane);
    } else if (PART == 3) {
        for (int it = gw; it < 2 * I_SQ; it += NGW) { if (it < I_SQ) transpose_item<0>(a.in[18], D, D, nullptr, (bf16_t*)(ws + WS_WAP), scr, it, lane); else transpose_item<0>(a.in[19], D, D, nullptr, (bf16_t*)(ws + WS_WO), scr, it - I_SQ, lane); }
    } else if (PART == 4) {
        for (int it = gw; it < I_UP; it += NGW) transpose_item<1>(a.in[21], D, 2 * FF, a.in[20], (bf16_t*)(ws + WS_W3), scr, it, lane);
    } else if (PART == 5) {
        for (int it = gw; it < I_DN; it += NGW) transpose_item<0>(a.in[22], FF, D, nullptr, (bf16_t*)(ws + WS_W4), scr, it, lane);
    }
    if (PART == 1) {
        const float* pw = a.in[11]; const float* psc = a.in[13]; const float* Wpp = a.in[17]; bf16_t* WcT = (bf16_t*)(ws + WS_WC);
        for (int it = gw; it < 512 * 4; it += NGW) {
            const int c = it >> 2, n = (it & 3) * 256 + lane * 4, g = c >> 7;
            f32x4 s = (f32x4){0.f, 0.f, 0.f, 0.f};
#pragma unroll 8
            for (int d = 0; d < 128; ++d) { const float coef = pw[(size_t)c * 128 + d] * psc[g * 128 + d]; s += *(const f32x4*)(Wpp + (size_t)(g * 128 + d) * D + n) * coef; }
#pragma unroll
            for (int j = 0; j < 4; ++j) WcT[(size_t)(n + j) * 512 + c] = (bf16_t)f2bf(s[j]);
        }
        const float* pb = a.in[12]; float* bcp = (float*)(ws + WS_BCP);
        for (int it = gw; it < 64; it += NGW) {
            const int kb = it >> 2, n = (it & 3) * 256 + lane * 4;
            f32x4 s = (f32x4){0.f, 0.f, 0.f, 0.f};
#pragma unroll 8
            for (int d = kb * 32; d < kb * 32 + 32; ++d) s += *(const f32x4*)(Wpp + (size_t)d * D + n) * (pb[d] * psc[d]);
            *(f32x4*)(bcp + kb * 1024 + n) = s;
        }
    }
    if (PART == 0) {
        bf16_t* xb = (bf16_t*)(ws + WS_XB); float* ss = (float*)(ws + WS_SS);
        for (int m = gw; m < MT; m += NGW) {
            const float* xr = (m < MP) ? a.in[0] + (size_t)m * D : a.in[1] + (size_t)(m - MP) * D;
            f32x4 v[4]; float s = 0.f;
#pragma unroll
            for (int j = 0; j < 4; ++j) { v[j] = *(const f32x4*)(xr + lane * 4 + 256 * j); s += (v[j][0] * v[j][0] + v[j][1] * v[j][1]) + (v[j][2] * v[j][2] + v[j][3] * v[j][3]); }
            s = wave_sum(s);
            const float rn = rsqrtf(s * (1.0f / 1024.0f) + EPS);
#pragma unroll
            for (int j = 0; j < 4; ++j) { const f32x4 t = v[j] * rn; u32x2 w; w.x = cvt_pk_bf16(t[0], t[1]); w.y = cvt_pk_bf16(t[2], t[3]); *(u32x2*)(xb + (size_t)m * D + lane * 4 + 256 * j) = w; }
            if (lane < 16) ss[(size_t)m * 16 + lane] = (lane == 0) ? s : 0.f;
        }
    }
    if (PART == 0) {
        const int gt = blockIdx.x * 512 + tid, NT = gridDim.x * 512;
        for (int i = gt; i < 2 * 16 * 96 * 32; i += NT) {
            const int which = i / (16 * 96 * 32), j = i % (16 * 96 * 32), b = j / (96 * 32), rem = j % (96 * 32);
            const float* src = a.in[3 + which] + (size_t)(b * 128 + 32) * 128 + rem * 4;
            float* dst = a.out + (which ? OFF_VS : OFF_KS) + (size_t)(b * 128) * 128 + rem * 4;
            *(f32x4*)dst = *(const f32x4*)src;
        }
    }
}

constexpr int KS_STRIDE = 144, VT_STRIDE = 400, LDS_KS = 0, LDS_VT = 192 * KS_STRIDE;
__device__ __forceinline__ int vt_pos(int key) { const int k = key & 15; return (key & ~15) + ((k >> 2) & 1) * 8 + (k & 3) + 4 * (k >> 3); }
__device__ __forceinline__ void attn_qblock(const bf16x8 (&qf)[4], int qrow0, int head, int nkb, const LAS unsigned char* Ks, const LAS unsigned char* VT, float sink2, bf16_t* yb, int lane) {
    const int qr = lane & 31, h = lane >> 5;
    f32x16 S[6];
#pragma unroll
    for (int kb = 0; kb < 6; ++kb) {
#pragma unroll
        for (int i = 0; i < 16; ++i) S[kb][i] = 0.f;
        if (kb < nkb) {
            const LAS unsigned char* kp = Ks + (kb * 32 + qr) * KS_STRIDE + 16 * h;
#pragma unroll
            for (int s = 0; s < 4; ++s) { const bf16x8 ka = *(const LAS bf16x8*)(kp + 32 * s); S[kb] = __builtin_amdgcn_mfma_f32_32x32x16_bf16(ka, qf[s], S[kb], 0, 0, 0); }
        }
    }
    float mx = sink2;
#pragma unroll
    for (int kb = 0; kb < 6; ++kb) if (kb < nkb) {
#pragma unroll
        for (int i = 0; i < 16; ++i) mx = fmaxf(mx, S[kb][i]);
    }
    mx = fmaxf(mx, __shfl_xor(mx, 32));
    float sum = 0.f;
    bf16x8 P[6][2];
#pragma unroll
    for (int kb = 0; kb < 6; ++kb) {
        if (kb < nkb) {
#pragma unroll
            for (int i = 0; i < 16; ++i) { const float p = __builtin_amdgcn_exp2f(S[kb][i] - mx); S[kb][i] = p; sum += p; }
        }
#pragma unroll
        for (int s = 0; s < 2; ++s) {
            u32x4 w; w.x = cvt_pk_bf16(S[kb][8 * s + 0], S[kb][8 * s + 1]); w.y = cvt_pk_bf16(S[kb][8 * s + 2], S[kb][8 * s + 3]);
            w.z = cvt_pk_bf16(S[kb][8 * s + 4], S[kb][8 * s + 5]); w.w = cvt_pk_bf16(S[kb][8 * s + 6], S[kb][8 * s + 7]);
            P[kb][s] = __builtin_bit_cast(bf16x8, w);
        }
    }
    sum += __shfl_xor(sum, 32);
    const float inv = 1.0f / (sum + __builtin_amdgcn_exp2f(sink2 - mx));
    f32x16 O[2];
#pragma unroll
    for (int db = 0; db < 2; ++db)
#pragma unroll
        for (int i = 0; i < 16; ++i) O[db][i] = 0.f;
#pragma unroll
    for (int kb = 0; kb < 6; ++kb) if (kb < nkb) {
#pragma unroll
        for (int s = 0; s < 2; ++s)
#pragma unroll
            for (int db = 0; db < 2; ++db) {
                const bf16x8 va = *(const LAS bf16x8*)(VT + (db * 32 + qr) * VT_STRIDE + (kb * 32 + 16 * s + 8 * h) * 2);
                O[db] = __builtin_amdgcn_mfma_f32_32x32x16_bf16(va, P[kb][s], O[db], 0, 0, 0);
            }
    }
    bf16_t* op = yb + (size_t)(qrow0 + qr) * 1024 + head * 64 + 4 * h;
#pragma unroll
    for (int db = 0; db < 2; ++db)
#pragma unroll
        for (int g = 0; g < 4; ++g) {
            u32x2 w; w.x = cvt_pk_bf16(O[db][4 * g + 0] * inv, O[db][4 * g + 1] * inv); w.y = cvt_pk_bf16(O[db][4 * g + 2] * inv, O[db][4 * g + 3] * inv);
            *(u32x2*)(op + db * 32 + 8 * g) = w;
        }
}

template <int W> __device__ __forceinline__ void pool_chunk(const float* u, const float* hist, bf16_t* pooled, int r0, int c) {
    const bool samp = r0 >= MP;
    const int s0 = samp ? ((r0 - MP) & 31) : (r0 & 4095);
    const float* hrow = hist + (size_t)(samp ? ((r0 - MP) >> 5) : 0) * 15 * 512 + c;
    f32x4 v[31];
#pragma unroll
    for (int i = 16 - W; i < 31; ++i) {
        const int sp = s0 - 15 + i;
        if (sp >= 0) v[i] = *(const f32x4*)(u + (size_t)(r0 - 15 + i) * 512 + c);
        else if (samp) v[i] = *(const f32x4*)(hrow + (15 + sp) * 512);
        else v[i] = (f32x4){0.f, 0.f, 0.f, 0.f};
    }
    f32x4 sum = (f32x4){0.f, 0.f, 0.f, 0.f};
#pragma unroll
    for (int i = 16 - W; i <= 15; ++i) sum += v[i];
#pragma unroll
    for (int k = 0; k < 16; ++k) {
        if (k) sum += v[15 + k] - v[15 + k - W];
        const int have = s0 + k + 1; const float cnt = samp ? (float)W : (float)(have < W ? have : W);
        const f32x4 o = sum * (1.0f / cnt) - v[15 + k];
        u32x2 wv; wv.x = cvt_pk_bf16(o[0], o[1]); wv.y = cvt_pk_bf16(o[2], o[3]);
        *(u32x2*)(pooled + (size_t)(r0 + k) * 512 + c) = wv;
    }
}

__device__ __forceinline__ void attn_pool_phase(const Args& a, LAS unsigned char* lds, int tid, int lane, int wave) {
    unsigned char* ws = a.ws;
    const bf16_t* q = (const bf16_t*)(ws + WS_Q); const bf16_t* kbuf = (const bf16_t*)(ws + WS_KB); const bf16_t* vbuf = (const bf16_t*)(ws + WS_VB);
    bf16_t* yb = (bf16_t*)a.out;
    LAS unsigned char* Ks = lds + LDS_KS; LAS unsigned char* VT = lds + LDS_VT;
    const float* sinks = a.in[16];
    { const int gt = blockIdx.x * 512 + tid; if (gt < 1024) { const float* bcp = (const float*)(ws + WS_BCP); float s = 0.f;
#pragma unroll
        for (int k = 0; k < 16; ++k) s += bcp[k * 1024 + gt]; ((float*)(ws + WS_BC))[gt] = s; } }
    for (int unit = blockIdx.x; unit < 544; unit += gridDim.x) {
        int nkeys, kvh, qrow0;
        if (unit < 512) { kvh = unit & 1; qrow0 = (unit >> 7) * 4096 + ((unit >> 1) & 63) * 64; } else { kvh = (unit - 512) & 1; qrow0 = MP + ((unit - 512) >> 1) * 32; }
        const int head = kvh * 8 + wave;
        __syncthreads();
        if (unit < 512) {
            const int c = (unit >> 1) & 63, b = unit >> 7; const int c0 = c < 2 ? 0 : c - 2;
            nkeys = 64 * (c - c0 + 1); const int krow0 = b * 4096 + c0 * 64;
            const int key0 = tid >> 3, ch = tid & 7;
            u32x4 kv[3], vv[3];
#pragma unroll
            for (int i = 0; i < 3; ++i) if (i * 64 < nkeys) { const size_t off = (size_t)(krow0 + i * 64 + key0) * 128 + kvh * 64 + ch * 8; kv[i] = *(const u32x4*)(kbuf + off); vv[i] = *(const u32x4*)(vbuf + off); }
#pragma unroll
            for (int i = 0; i < 3; ++i) if (i * 64 < nkeys) { const int key = i * 64 + key0;
                *(LAS u32x4*)(Ks + key * KS_STRIDE + ch * 16) = kv[i];
#pragma unroll
                for (int e = 0; e < 8; ++e) *(LAS unsigned short*)(VT + (ch * 8 + e) * VT_STRIDE + vt_pos(key) * 2) = (unsigned short)((vv[i][e >> 1] >> (16 * (e & 1))) & 0xffffu); }
        } else {
            const int su = unit - 512; const int b = su >> 1; nkeys = 160;
            for (int it = tid; it < nkeys * 8; it += 512) {
                const int key = it >> 3, ch = it & 7; u32x4 kv, vv;
                if (key < 128) {
                    const size_t off = (size_t)((b * 128 + key) * 2 + kvh) * 64 + ch * 8;
                    const f32x4 k0 = *(const f32x4*)(a.in[3] + off), k1 = *(const f32x4*)(a.in[3] + off + 4), v0 = *(const f32x4*)(a.in[4] + off), v1 = *(const f32x4*)(a.in[4] + off + 4);
                    kv = (u32x4){cvt_pk_bf16(k0[0], k0[1]), cvt_pk_bf16(k0[2], k0[3]), cvt_pk_bf16(k1[0], k1[1]), cvt_pk_bf16(k1[2], k1[3])};
                    vv = (u32x4){cvt_pk_bf16(v0[0], v0[1]), cvt_pk_bf16(v0[2], v0[3]), cvt_pk_bf16(v1[0], v1[1]), cvt_pk_bf16(v1[2], v1[3])};
                } else {
                    const size_t off = (size_t)(MP + b * 32 + key - 128) * 128 + kvh * 64 + ch * 8;
                    kv = *(const u32x4*)(kbuf + off); vv = *(const u32x4*)(vbuf + off);
                }
                *(LAS u32x4*)(Ks + key * KS_STRIDE + ch * 16) = kv;
#pragma unroll
                for (int i = 0; i < 8; ++i) *(LAS unsigned short*)(VT + (ch * 8 + i) * VT_STRIDE + vt_pos(key) * 2) = (unsigned short)((vv[i >> 1] >> (16 * (i & 1))) & 0xffffu);
            }
        }
        __syncthreads();
        const float sink2 = sinks[head] * LOG2E; const int nkb = nkeys >> 5;
        bf16x8 qf0[4];
        const bf16_t* qp = q + (size_t)(qrow0 + (lane & 31)) * 1024 + head * 64 + 8 * (lane >> 5);
#pragma unroll
        for (int s = 0; s < 4; ++s) qf0[s] = *(const bf16x8*)(qp + 16 * s);
        attn_qblock(qf0, qrow0, head, nkb, Ks, VT, sink2, yb, lane);
        if (unit < 512) {
#pragma unroll
            for (int s = 0; s < 4; ++s) qf0[s] = *(const bf16x8*)(q + (size_t)(qrow0 + 32 + (lane & 31)) * 1024 + head * 64 + 8 * (lane >> 5) + 16 * s);
            attn_qblock(qf0, qrow0 + 32, head, nkb, Ks, VT, sink2, yb, lane);
        }
    }
    {
        const float* u = (const float*)(ws + WS_U); bf16_t* pooled = (bf16_t*)(ws + WS_POOLED); const float* hist = a.in[2];
        const int gwv = blockIdx.x * 8 + wave, NW = gridDim.x * 8;
        for (int it = gwv; it < (MT / 32) * 4; it += NW) {
            const int g = it & 3, r0 = ((it >> 2) * 2 + (lane >> 5)) * 16, c = g * 128 + (lane & 31) * 4;
            if (g == 0) pool_chunk<2>(u, hist, pooled, r0, c); else if (g == 1) pool_chunk<4>(u, hist, pooled, r0, c); else if (g == 2) pool_chunk<8>(u, hist, pooled, r0, c); else pool_chunk<16>(u, hist, pooled, r0, c);
        }
    }
}

#define XB_TMO      128
#define XB_XCNT(j)  (256  + 64 * (j))
#define XB_XSUB(j)  (1280 + 64 * (j))
#define XB_XGEN(j)  (2304 + 64 * (j))
#define XB_TOP      3328
#define XB_TOPGEN   3392
#define XCD_BAR_WORDS 3456
#define XB_SPIN_CAP (1u << 18)

__device__ __forceinline__ unsigned xb_ld(unsigned* p)              { return __hip_atomic_load(p, __ATOMIC_RELAXED, __HIP_MEMORY_SCOPE_AGENT); }
__device__ __forceinline__ unsigned xb_add(unsigned* p, unsigned v) { return __hip_atomic_fetch_add(p, v, __ATOMIC_RELAXED, __HIP_MEMORY_SCOPE_AGENT); }
__device__ __forceinline__ unsigned xb_xcc_id() { return (unsigned)__builtin_amdgcn_s_getreg((3 << 11) | 20) & 0xFu; }
#define XB_SPIN(cond, bar) do { unsigned _sp = 0; while (cond) { __builtin_amdgcn_s_sleep(1); \
    if ((++_sp & 255u) == 0u) { if (xb_ld(&(bar)[XB_TMO])) break; if (_sp > XB_SPIN_CAP) { atomicAdd(&(bar)[XB_TMO], 1u); break; } } } } while (0)

struct XcdBarrier {
    unsigned* bar; unsigned x;
    volatile LAS unsigned* st;
};

__device__ __forceinline__ XcdBarrier xcd_barrier_post(unsigned* bar, volatile LAS unsigned* st) {
    XcdBarrier b; b.bar = bar; b.x = xb_xcc_id(); b.st = st;
    if (threadIdx.x == 0) (void)xb_add(&bar[XB_XCNT(b.x)], 1u);
    return b;
}
__device__ __forceinline__ void xcd_barrier_complete(unsigned* bar, unsigned x, unsigned& nloc, unsigned& nx) {
    const unsigned G = gridDim.x * gridDim.y * gridDim.z;
    unsigned sum, cnt, mine, sp = 0u;
    for (;;) {
        sum = 0u; cnt = 0u; mine = 0u;
#pragma unroll
        for (unsigned j = 0; j < 16; ++j) { const unsigned c = xb_ld(&bar[XB_XCNT(j)]); sum += c; cnt += (c > 0u) ? 1u : 0u; mine = (j == x) ? c : mine; }
        if (sum == G) break;
        __builtin_amdgcn_s_sleep(1);
        if ((++sp & 255u) == 0u) { if (xb_ld(&bar[XB_TMO])) break; if (sp > XB_SPIN_CAP) { atomicAdd(&bar[XB_TMO], 1u); break; } }
    }
    nloc = mine > 0u ? mine : 1u; nx = cnt > 0u ? cnt : 1u;
}

__device__ __forceinline__ void xcd_barrier(const XcdBarrier& b) {
    asm volatile("s_waitcnt vmcnt(0)" ::: "memory");
    __syncthreads();
    if (threadIdx.x == 0) {
        unsigned* bar = b.bar;
        __builtin_amdgcn_s_waitcnt(0);
        unsigned nloc = b.st[0], nx = b.st[1];
        if (nloc == 0u) { xcd_barrier_complete(bar, b.x, nloc, nx); b.st[0] = nloc; b.st[1] = nx; }
        const unsigned old = xb_add(&bar[XB_XSUB(b.x)], 1u);
        const unsigned gen = old / nloc;
        if (old + 1u == (gen + 1u) * nloc) {
            __builtin_amdgcn_fence(__ATOMIC_RELEASE, "agent");
            asm volatile("s_waitcnt vmcnt(0)" ::: "memory");
            const unsigned og = xb_add(&bar[XB_TOP], 1u);
            const unsigned tg = og / nx;
            if (og + 1u == (tg + 1u) * nx) xb_add(&bar[XB_TOPGEN], 1u);
            else XB_SPIN(xb_ld(&bar[XB_TOPGEN]) == tg, bar);
            __builtin_amdgcn_fence(__ATOMIC_ACQUIRE, "agent");
            xb_add(&bar[XB_XGEN(b.x)], 1u);
            asm volatile("s_waitcnt vmcnt(0)" ::: "memory");
        } else {
            XB_SPIN(xb_ld(&bar[XB_XGEN(b.x)]) == gen, bar);
            __builtin_amdgcn_fence(__ATOMIC_ACQUIRE, "agent");
            asm volatile("s_waitcnt vmcnt(0)" ::: "memory");
        }
    }
    __syncthreads();
}

constexpr int LDS_BYTES = 143360;
#define GEMM_PHASE_M(EPI, M_, A_, B_, N_, K_, E_) do { pg8::Gemm g_{(const bf16_t*)(A_), (const bf16_t*)(B_), (M_), (N_), (K_), (K_), 0}; pg8::StaticOrder S_; S_.init((M_), (N_), (int)gridDim.x, (int)blockIdx.x); \
        pg8::gemm_phase<EPI, pg8::StaticOrder, true, true>(lds, g_, S_, (E_)); } while (0)
#define GEMM_PHASE(EPI, A_, B_, N_, K_, E_) GEMM_PHASE_M(EPI, MT, A_, B_, N_, K_, E_)
#define GEMM_PHASE_IDX(EPI, A_, B_, N_, K_, E_) do { pg8::Gemm g_{(const bf16_t*)(A_), (const bf16_t*)(B_), MT, (N_), (K_), (K_), 0}; IndexedOrder S_; S_.init(MT, (N_), (int)gridDim.x, (int)blockIdx.x); \
        pg8::gemm_phase<EPI, IndexedOrder, true, true>(lds, g_, S_, (E_)); } while (0)
#define COMBO_PHASE(EPI, A_, B_, K_, S_, SOFF_, E_) do { pg8::Gemm g_{(const bf16_t*)(A_), (const bf16_t*)(B_), MT, D, (K_), (K_), 512}; ComboOrder<S_> S_o; \
        S_o.init(MP, D, (int)gridDim.x, (int)blockIdx.x); S_o.soff = (SOFF_); pg8::gemm_phase<EPI, ComboOrder<S_>, true, true>(lds, g_, S_o, (E_)); } while (0)

struct IndexedOrder : pg8::StaticOrder {
    __device__ bool next(int i, Unit& u) const { const bool ok = pg8::StaticOrder::next(i, u); u.ks = i; return ok; }
};
constexpr int LDS_RS = 131072 + 64, RS_MAX_UNITS = 7;
__device__ __forceinline__ void rs_table(LAS unsigned char* lds, const float* ss, int N, int tid, const float* bgate) {
    IndexedOrder S; S.init(MT, N, (int)gridDim.x, (int)blockIdx.x); Unit u; LAS float* lrs = (LAS float*)(lds + LDS_RS);
    for (int i = 0; i < RS_MAX_UNITS && S.next(i, u); ++i) if (tid < 256) { lrs[i * 256 + tid] = rstd_of(ss, u.pm * 256 + tid);
        if (bgate && i < 4 && u.pn >= 7) lrs[LDS_T2_OFF + i * 256 + tid] = bgate[(u.pn - 7) * 256 + tid]; }
    __syncthreads();
}
#define IDLE_CONVERT(PART_, FIRST_) do { const int f_ = (FIRST_), G_ = (int)gridDim.x; \
        if (f_ > 0 && f_ < G_) { if ((int)blockIdx.x >= f_) prologue<PART_>(a, lds, tid, lane, wave, ((int)blockIdx.x - f_) * 8 + wave, (G_ - f_) * 8); } \
        else prologue<PART_>(a, lds, tid, lane, wave, (int)blockIdx.x * 8 + wave, G_ * 8); } while (0)

__global__ void __launch_bounds__(512, 2) mk_fwd(Args a) {
    extern __shared__ __attribute__((aligned(16))) unsigned char lds_raw[];
    LAS unsigned char* lds = (LAS unsigned char*)lds_raw;
    cg::grid_group grid = cg::this_grid();
    const int tid = threadIdx.x, lane = tid & 63, wave = __builtin_amdgcn_readfirstlane(tid >> 6);
    unsigned char* ws = a.ws;
    float* ss = (float*)(ws + WS_SS);
    bf16_t* xb = (bf16_t*)(ws + WS_XB); bf16_t* act = (bf16_t*)(ws + WS_ACT);
    float* y = a.out;

    if (tid < 16) ((LAS unsigned*)(lds + 131072))[tid] = 0u;
    if (blockIdx.x == 0 && tid < 17) { unsigned* bw = (unsigned*)(ws + WS_BAR);
        if (tid < 16) { __hip_atomic_store(bw + XB_XCNT(tid), 0u, __ATOMIC_RELAXED, __HIP_MEMORY_SCOPE_AGENT); __hip_atomic_store(bw + XB_XSUB(tid), 0u, __ATOMIC_RELAXED, __HIP_MEMORY_SCOPE_AGENT); __hip_atomic_store(bw + XB_XGEN(tid), 0u, __ATOMIC_RELAXED, __HIP_MEMORY_SCOPE_AGENT); }
        else { __hip_atomic_store(bw + XB_TMO, 0u, __ATOMIC_RELAXED, __HIP_MEMORY_SCOPE_AGENT); __hip_atomic_store(bw + XB_TOP, 0u, __ATOMIC_RELAXED, __HIP_MEMORY_SCOPE_AGENT); __hip_atomic_store(bw + XB_TOPGEN, 0u, __ATOMIC_RELAXED, __HIP_MEMORY_SCOPE_AGENT); } }
    __syncthreads();
    XcdBarrier bar; bar.bar = (unsigned*)(ws + WS_BAR); bar.x = xb_xcc_id(); bar.st = (volatile LAS unsigned*)(lds + 131072);
    grid.sync();
    if (tid == 0) (void)xb_add(&bar.bar[XB_XCNT(bar.x)], 1u);
    prologue<0>(a, lds, tid, lane, wave, blockIdx.x * 8 + wave, gridDim.x * 8);
    xcd_barrier(bar);
    { EpiSwiglu<false> E{act, nullptr}; GEMM_PHASE(EpiSwiglu<false>, xb, ws + WS_W1, 2 * FF, D, E); }
    IDLE_CONVERT(2, ((MT / 256) * (2 * FF / 256)) % (int)gridDim.x);
    xcd_barrier(bar);
    { EpiResid<0> E{a.in[0], a.in[1], y, xb, ss, 0.5f, (float*)(ws + WS_R)}; COMBO_PHASE(EpiResid<0>, act, ws + WS_W2, FF, 11, 0, E); }
    xcd_barrier(bar);
    reduce_resid<11, 0>((const float*)(ws + WS_R), a.in[1], y, xb, ss, 0.5f, lane, wave);
    prologue<1>(a, lds, tid, lane, wave, blockIdx.x * 8 + wave, gridDim.x * 8);
    xcd_barrier(bar);
    rs_table(lds, ss, DIN, tid, a.in[10]);
    { EpiWin E{(const LAS float*)(lds + LDS_RS), (float*)(ws + WS_U), (bf16_t*)(ws + WS_Q), (bf16_t*)(ws + WS_KB), (bf16_t*)(ws + WS_VB), (bf16_t*)(ws + WS_GATES), a.in[10], a.in[14], a.in[15], a.out};
      GEMM_PHASE_IDX(EpiWin, xb, ws + WS_WIN, DIN, D, E); }
    IDLE_CONVERT(3, ((MT / 256) * (DIN / 256)) % (int)gridDim.x);
    xcd_barrier(bar);
    attn_pool_phase(a, lds, tid, lane, wave);
    xcd_barrier(bar);
    { EpiMix1 E{(const bf16_t*)(ws + WS_GATES), (const float*)(ws + WS_BC), (bf16_t*)(ws + WS_T), (float*)(ws + WS_SLAB5A)}; COMBO_PHASE(EpiMix1, ws + WS_POOLED, ws + WS_WC, DPOOL, 2, 0, E); }
    { EpiMix2 E{(const bf16_t*)(ws + WS_GATES), (const bf16_t*)(ws + WS_T), (bf16_t*)(ws + WS_MIX), (float*)(ws + WS_SLAB5B)}; COMBO_PHASE(EpiMix2, a.out, ws + WS_WAP, D, 4, 16, E); }
    IDLE_CONVERT(4, 48);
    xcd_barrier(bar);
    reduce_mix<2, 4>((const float*)(ws + WS_SLAB5A), (const float*)(ws + WS_SLAB5B), (const bf16_t*)(ws + WS_GATES), (const float*)(ws + WS_BC), (bf16_t*)(ws + WS_MIX), lane, wave);
    xcd_barrier(bar);
    { EpiResid<1> E{nullptr, nullptr, y, xb, ss, 1.0f, (float*)(ws + WS_T)}; COMBO_PHASE(EpiResid<1>, ws + WS_MIX, ws + WS_WO, D, 4, 0, E); }
    xcd_barrier(bar);
    reduce_resid<4, 1>((const float*)(ws + WS_T), nullptr, y, xb, ss, 1.0f, lane, wave);
    xcd_barrier(bar);
    rs_table(lds, ss, 2 * FF, tid, nullptr);
    { EpiSwiglu<true> E{act, (const LAS float*)(lds + LDS_RS)}; GEMM_PHASE_IDX(EpiSwiglu<true>, xb, ws + WS_W3, 2 * FF, D, E); }
    IDLE_CONVERT(5, ((MT / 256) * (2 * FF / 256)) % (int)gridDim.x);
    xcd_barrier(bar);
    { EpiResid<2> E{nullptr, nullptr, y, xb, nullptr, 0.5f, (float*)(ws + WS_R)}; COMBO_PHASE(EpiResid<2>, act, ws + WS_W4, FF, 11, 0, E); }
    xcd_barrier(bar);
    reduce_resid<11, 2>((const float*)(ws + WS_R), nullptr, y, xb, nullptr, 0.5f, lane, wave);
}
}

extern "C" void kernel_launch(void* const* d_in, const int* in_sizes, int n_in, void* d_out, int out_size, void* d_ws, size_t ws_size, hipStream_t stream) {
    static int grid = 0;
    if (grid == 0) {
        if (n_in != 23 || out_size != (int)mk::OUT_TOTAL || ws_size < mk::WS_END) { fprintf(stderr, "kernel_launch: unexpected shapes (n_in %d out %d ws %zu)\n", n_in, out_size, ws_size); grid = -1; return; }
        int dev = 0, cus = 0, per_cu = 0;
        hipGetDevice(&dev); hipDeviceGetAttribute(&cus, hipDeviceAttributeMultiprocessorCount, dev);
        hipFuncSetAttribute((const void*)mk::mk_fwd, hipFuncAttributeMaxDynamicSharedMemorySize, mk::LDS_BYTES);
        hipOccupancyMaxActiveBlocksPerMultiprocessor(&per_cu, (const void*)mk::mk_fwd, 512, mk::LDS_BYTES);
        if (per_cu < 1) per_cu = 1;
        grid = cus * per_cu;
        if (grid * 7 < 66 * 22 || grid * 4 < 66 * 15) { fprintf(stderr, "kernel_launch: %d workgroups; the per-phase row-factor table holds 7 tiles per workgroup (needs >= 208 workgroups)\n", grid); grid = -1; return; }
    }
    if (grid < 0) return;
    mk::Args a{};
    for (int i = 0; i < 23; ++i) a.in[i] = (const float*)d_in[i];
    a.out = (float*)d_out; a.ws = (unsigned char*)d_ws;
    void* args[] = {&a};
    hipError_t e = hipLaunchCooperativeKernel((const void*)mk::mk_fwd, dim3(grid), dim3(512), args, mk::LDS_BYTES, stream);
    if (e != hipSuccess) fprintf(stderr, "cooperative launch failed: %s (grid %d)\n", hipGetErrorString(e), grid);
}
```
